# Optimizing an MI355X kernel written in HIP

```python
import jax, jax.numpy as jnp
from jax import lax
import numpy as np

D_MODEL = 1024
BATCH = 4
SEQ = 8192
DEPTH = 1

RET_HEADS = 4
RET_DK = 128
RET_DV = 256
RET_CHUNK = 128
ROPE_BASE = 10000.0
MOBA_HEADS = 8
MOBA_DH = 64
MOBA_BLOCK = 256
MOBA_TOPK = 3
MOBA_QBLOCK = 64
FFN_HIDDEN = ((8 * D_MODEL + 3 * 256 - 1) // (3 * 256)) * 256

RET_QK = RET_HEADS * RET_DK
RET_V = RET_HEADS * RET_DV
MOBA_W = MOBA_HEADS * MOBA_DH
IN_SPLITS = (RET_QK, RET_QK, RET_V, RET_V, MOBA_W, MOBA_W, MOBA_W, D_MODEL, D_MODEL)
IN_COLS = sum(IN_SPLITS)

RMS_EPS = 1e-6
GN_EPS = 1e-5
NEG = -1e30

kernel_name = "hybrid_retention_moba_block"


def rmsnorm(x, w):
    xf = x.astype(jnp.float32)
    y = xf * lax.rsqrt(jnp.mean(xf * xf, axis=-1, keepdims=True) + RMS_EPS)
    return (y * w.astype(jnp.float32)).astype(x.dtype)


def rotary(x, pos):
    half = x.shape[-1] // 2
    inv = ROPE_BASE ** (-jnp.arange(half, dtype=jnp.float32) / half)
    ang = pos.astype(jnp.float32)[:, None] * inv[None, :]
    cos = jnp.cos(ang)[None, :, None, :].astype(x.dtype)
    sin = jnp.sin(ang)[None, :, None, :].astype(x.dtype)
    x1, x2 = x[..., :half], x[..., half:]
    return jnp.concatenate([x1 * cos - x2 * sin, x2 * cos + x1 * sin], axis=-1)


def retention(q, k, v):
    B, S, H, _ = q.shape
    dv = v.shape[-1]
    C = RET_CHUNK
    NC = S // C
    dt = q.dtype

    def chunks(t):
        return t.reshape(B, NC, C, H, t.shape[-1]).transpose(0, 3, 1, 2, 4)

    qc, kc, vc = chunks(q), chunks(k), chunks(v)
    lg = jnp.log1p(-jnp.exp2(-5.0 - jnp.arange(H, dtype=jnp.float32)))
    idx = jnp.arange(C, dtype=jnp.float32)
    diff = idx[:, None] - idx[None, :]
    dmat = jnp.where(diff >= 0, jnp.exp(jnp.maximum(diff, 0.0)[None] * lg[:, None, None]), 0.0).astype(dt)
    xi = jnp.exp((idx + 1.0)[None, :] * lg[:, None]).astype(dt)
    zeta = jnp.exp((C - 1.0 - idx)[None, :] * lg[:, None]).astype(dt)
    g_chunk = jnp.exp(C * lg).astype(dt)

    scores = jnp.einsum('bhcnd,bhcmd->bhcnm', qc, kc) * dmat[None, :, None]
    o_inner = jnp.einsum('bhcnm,bhcme->bhcne', scores, vc)
    upd = jnp.einsum('bhcmd,bhcme->bhcde', kc * zeta[None, :, None, :, None], vc)
    upd = jnp.moveaxis(upd, 2, 0)

    def step(state, u):
        return g_chunk[None, :, None, None] * state + u, state

    _, r_prev = lax.scan(step, jnp.zeros_like(upd[0]), upd)
    r_prev = jnp.moveaxis(r_prev, 0, 2)
    o_cross = jnp.einsum('bhcnd,bhcde->bhcne', qc * xi[None, :, None, :, None], r_prev)
    o = (o_inner + o_cross).transpose(0, 2, 3, 1, 4).reshape(B, S, H, dv)
    of = o.astype(jnp.float32)
    mu = jnp.mean(of, axis=-1, keepdims=True)
    var = jnp.mean(jnp.square(of - mu), axis=-1, keepdims=True)
    o = ((of - mu) * lax.rsqrt(var + GN_EPS)).astype(dt)
    return o.reshape(B, S, H * dv)


def gather_blocks(blocks, sel):
    return jax.vmap(jax.vmap(lambda bl, ix: bl[ix]))(blocks, sel)


def moba_attention(q, k, v):
    B, S, H, dh = q.shape
    BLK, QB = MOBA_BLOCK, MOBA_QBLOCK
    sp = ((S + BLK - 1) // BLK) * BLK
    pad = ((0, 0), (0, sp - S), (0, 0), (0, 0))
    qh = jnp.pad(q, pad).transpose(0, 2, 1, 3)
    kh = jnp.pad(k, pad).transpose(0, 2, 1, 3)
    vh = jnp.pad(v, pad).transpose(0, 2, 1, 3)
    nb = sp // BLK
    kb = kh.reshape(B, H, nb, BLK, dh)
    vb = vh.reshape(B, H, nb, BLK, dh)
    kbar = jnp.mean(kb, axis=3)
    topk = min(MOBA_TOPK, nb)
    scale = dh ** -0.5
    n_qb = sp // QB

    def one_block(qi):
        start = qi * QB
        blk = start // BLK
        qb = lax.dynamic_slice_in_dim(qh, start, QB, axis=2)
        gate = jnp.einsum('bhqd,bhnd->bhqn', qb, kbar).astype(jnp.float32)
        gate = jnp.where(jnp.arange(nb)[None, None, None, :] < blk, gate, NEG)
        _, sel = lax.top_k(gate, topk)
        valid = sel < blk
        ks = gather_blocks(kb, sel)
        vs = gather_blocks(vb, sel)
        s_sel = jnp.einsum('bhqd,bhqkjd->bhqkj', qb, ks).astype(jnp.float32) * scale
        s_sel = jnp.where(valid[..., None], s_sel, NEG).reshape(B, H, QB, topk * BLK)
        k_own = lax.dynamic_index_in_dim(kb, blk, axis=2, keepdims=False)
        v_own = lax.dynamic_index_in_dim(vb, blk, axis=2, keepdims=False)
        s_own = jnp.einsum('bhqd,bhjd->bhqj', qb, k_own).astype(jnp.float32) * scale
        qpos = start + jnp.arange(QB)
        kpos = blk * BLK + jnp.arange(BLK)
        s_own = jnp.where(kpos[None, :] <= qpos[:, None], s_own, NEG)
        p = jax.nn.softmax(jnp.concatenate([s_sel, s_own], axis=-1), axis=-1)
        p_sel = p[..., :topk * BLK].reshape(B, H, QB, topk, BLK).astype(v.dtype)
        p_own = p[..., topk * BLK:].astype(v.dtype)
        return (jnp.einsum('bhqkj,bhqkjd->bhqd', p_sel, vs)
                + jnp.einsum('bhqj,bhjd->bhqd', p_own, v_own))

    out = lax.map(one_block, jnp.arange(n_qb))
    out = out.transpose(1, 0, 3, 2, 4).reshape(B, sp, H * dh)
    return out[:, :S]


def setup_inputs(seed: int = 0) -> dict:
    key = jax.random.key(seed)
    ks = jax.random.split(key, 12)

    def w(k, shape, fan_in):
        return jax.random.normal(k, shape, jnp.float32) * fan_in ** -0.5

    def gain(k, shape):
        return 1.0 + 0.02 * jax.random.normal(k, shape, jnp.float32)

    return {
        "x": jax.random.normal(ks[0], (BATCH, SEQ, D_MODEL), jnp.float32),
        "norm1_w": gain(ks[1], (DEPTH, D_MODEL)),
        "w_in": w(ks[2], (DEPTH, D_MODEL, IN_COLS), D_MODEL),
        "q_norm_w": gain(ks[3], (DEPTH, MOBA_DH)),
        "k_norm_w": gain(ks[4], (DEPTH, MOBA_DH)),
        "w_ret_out": w(ks[5], (DEPTH, RET_V, D_MODEL), RET_V),
        "w_moba_out": w(ks[6], (DEPTH, MOBA_W, D_MODEL), MOBA_W),
        "w_o": w(ks[7], (DEPTH, D_MODEL, D_MODEL), D_MODEL),
        "norm2_w": gain(ks[8], (DEPTH, D_MODEL)),
        "w_ffn_gate": w(ks[9], (DEPTH, D_MODEL, FFN_HIDDEN), D_MODEL),
        "w_ffn_up": w(ks[10], (DEPTH, D_MODEL, FFN_HIDDEN), D_MODEL),
        "w_ffn_down": w(ks[11], (DEPTH, FFN_HIDDEN, D_MODEL), FFN_HIDDEN),
    }


def reference(x, norm1_w, w_in, q_norm_w, k_norm_w, w_ret_out, w_moba_out, w_o,
              norm2_w, w_ffn_gate, w_ffn_up, w_ffn_down):
    B, S, _ = x.shape
    pos = jnp.arange(S)
    split_points = [int(v) for v in np.cumsum(IN_SPLITS)[:-1]]
    for l in range(DEPTH):
        h = rmsnorm(x, norm1_w[l])
        proj = h @ w_in[l]
        rq, rk, rv, rg, mq, mk, mv, ga, gb = jnp.split(proj, split_points, axis=-1)

        rq = rotary(rq.reshape(B, S, RET_HEADS, RET_DK), pos)
        rk = rotary(rk.reshape(B, S, RET_HEADS, RET_DK), pos) * (RET_DK ** -0.5)
        rv = rv.reshape(B, S, RET_HEADS, RET_DV)
        ret = jax.nn.silu(rg) * retention(rq, rk, rv)
        a = ret @ w_ret_out[l]

        mq = rmsnorm(mq.reshape(B, S, MOBA_HEADS, MOBA_DH), q_norm_w[l])
        mk = rmsnorm(mk.reshape(B, S, MOBA_HEADS, MOBA_DH), k_norm_w[l])
        mv = mv.reshape(B, S, MOBA_HEADS, MOBA_DH)
        b = moba_attention(mq, mk, mv) @ w_moba_out[l]

        mix = jax.nn.sigmoid(ga) * a + jax.nn.sigmoid(gb) * b
        x = x + mix @ w_o[l]

        h2 = rmsnorm(x, norm2_w[l])
        f = (jax.nn.silu(h2 @ w_ffn_gate[l]) * (h2 @ w_ffn_up[l])) @ w_ffn_down[l]
        x = x + f
    return x
```

```cpp
#include <hip/hip_runtime.h>
#include <hip/hip_cooperative_groups.h>
#include <cstdio>
#include <cstdint>
#include <type_traits>
namespace cg = cooperative_groups;

#define DI __device__ __forceinline__
#define LAS __attribute__((address_space(3)))
typedef unsigned short bf16_t;
typedef short bf16x8 __attribute__((ext_vector_type(8)));
typedef float f32x4 __attribute__((ext_vector_type(4)));
typedef float f32x2 __attribute__((ext_vector_type(2)));
typedef __bf16 bf16v2 __attribute__((ext_vector_type(2)));
typedef unsigned u32x2 __attribute__((ext_vector_type(2)));
typedef unsigned u32x4 __attribute__((ext_vector_type(4)));

constexpr int T_TOK = 32768, SEQ = 8192, DM = 1024, NCOL = 6656, FH = 2816;
constexpr int NTHREADS = 512;
constexpr int LDS_BYTES = 147456;
constexpr size_t MiB = 1048576;
constexpr size_t OFF_WIN = 0;
constexpr size_t OFF_WRO = OFF_WIN + 13 * MiB;
constexpr size_t OFF_WMO = OFF_WRO + 2 * MiB;
constexpr size_t OFF_WO  = OFF_WMO + 1 * MiB;
constexpr size_t OFF_WGU = OFF_WO + 2 * MiB;
constexpr size_t OFF_WD  = OFF_WGU + 11 * MiB;
constexpr size_t OFF_QR  = OFF_WD + 6 * MiB;
constexpr size_t OFF_KR  = OFF_QR + 32 * MiB;
constexpr size_t OFF_KRT = OFF_KR + 32 * MiB;
constexpr size_t OFF_VRT = OFF_KRT + 32 * MiB;
constexpr size_t OFF_G   = OFF_VRT + 64 * MiB;
constexpr size_t OFF_MQ  = OFF_G + 64 * MiB;
constexpr size_t OFF_MK  = OFF_MQ + 32 * MiB;
constexpr size_t OFF_MVT = OFF_MK + 32 * MiB;
constexpr size_t OFF_GA  = OFF_MVT + 32 * MiB;
constexpr size_t OFF_GB  = OFF_GA + 64 * MiB;
constexpr size_t OFF_MISC = OFF_GB + 64 * MiB;
constexpr size_t OFF_COS = OFF_MISC;
constexpr size_t OFF_SIN = OFF_COS + 2 * MiB;
constexpr size_t OFF_RSTD1 = OFF_SIN + 2 * MiB;
constexpr size_t OFF_SSQ = OFF_RSTD1 + 131072;
constexpr size_t OFF_KBAR = OFF_SSQ + 4 * 131072;
constexpr size_t OFF_SC = OFF_KBAR + 262144;
constexpr size_t OFF_BAR = OFF_SC + 4096;
constexpr size_t WS_END = OFF_BAR + 16384;
constexpr size_t OFF_X1B = OFF_QR;
constexpr size_t OFF_HID = OFF_KRT;

struct Params {
  const float *x, *norm1_w, *w_in, *q_norm_w, *k_norm_w, *w_ret_out, *w_moba_out, *w_o, *norm2_w, *w_gate, *w_up, *w_down;
  float* out;
  unsigned char* ws;
};

DI unsigned pk2(float lo, float hi) { f32x2 v = {lo, hi}; bf16v2 b = __builtin_convertvector(v, bf16v2); return __builtin_bit_cast(unsigned, b); }
DI bf16_t f2bf(float x) { return (bf16_t)(pk2(x, 0.f) & 0xffffu); }
DI u32x2 pk4(f32x4 v) { u32x2 r; r.x = pk2(v[0], v[1]); r.y = pk2(v[2], v[3]); return r; }
DI float bf2f(bf16_t v) { return __uint_as_float(((unsigned)v) << 16); }
DI f32x4 unpk4(u32x2 u) { f32x4 r; r[0] = __uint_as_float(u.x << 16); r[1] = __uint_as_float(u.x & 0xffff0000u); r[2] = __uint_as_float(u.y << 16); r[3] = __uint_as_float(u.y & 0xffff0000u); return r; }
DI float lg2gamma(int h) { return h == 0 ? -0.045803689613124f : (h == 1 ? -0.022720076500083f : (h == 2 ? -0.011315313227834f : -0.005646563141142f)); }
DI float fast_exp2(float x) { return __builtin_amdgcn_exp2f(x); }
DI float sigmoidf_(float v) { return __builtin_amdgcn_rcpf(1.f + fast_exp2(-1.4426950408889634f * v)); }
#define MFMA16(a, b, c) __builtin_amdgcn_mfma_f32_16x16x32_bf16((a), (b), (c), 0, 0, 0)

DI int lds_byte(int r, int c) { const int st = (r >> 4) * 2 + (c >> 5), rr = r & 15, cc = c & 31, ob = rr * 64 + cc * 2; return st * 1024 + (ob ^ (((ob >> 9) & 1) << 5)); }
DI void stage_rc(int b, int& R, int& C) { const int st = b / 1024, sb = b % 1024, swz = sb ^ (((sb >> 9) & 1) << 5); R = (st >> 1) * 16 + swz / 64; C = (st & 1) * 32 + (swz % 64) / 2; }
DI void glds16(const bf16_t* g, LAS unsigned char* l) {
  __builtin_amdgcn_global_load_lds((const __attribute__((address_space(1))) unsigned*)g, (LAS unsigned*)l, 16, 0, 0);
}

DI void gemm_main(const bf16_t* Ap, long lda, long ksa, const bf16_t* Bp, long ldb, long ksb, int nt, LAS unsigned char* shm, f32x4 (&acc)[2][2][4][2], const bool pre = false) {
  int tid_ = threadIdx.x; asm volatile("" : "+v"(tid_)); const int tid = tid_, wid = __builtin_amdgcn_readfirstlane(tid >> 6), lane = tid & 63, wr = wid >> 2, wc = wid & 3, fr = lane & 15, fq = lane >> 4;
  int voffA[2], voffB[2];
#pragma unroll
  for (int i = 0; i < 2; ++i) { int R, C; stage_rc(tid * 16 + i * 8192, R, C); voffA[i] = R * (int)lda + C; voffB[i] = R * (int)ldb + C; }
  const int aoff = lds_byte(wr * 64 + fr, fq * 8), boff = lds_byte(wc * 32 + fr, fq * 8);
  LAS unsigned char* ldsw = shm + wid * 1024;
  const long hA = 128 * lda, hB = 128 * ldb;
#pragma unroll
  for (int ai = 0; ai < 2; ++ai)
#pragma unroll
    for (int bj = 0; bj < 2; ++bj)
#pragma unroll
      for (int m = 0; m < 4; ++m)
#pragma unroll
        for (int n = 0; n < 2; ++n) acc[ai][bj][m][n] = (f32x4){0.f, 0.f, 0.f, 0.f};
  bf16x8 At[4][2], B0[2][2], B1[2][2];
#define G_SA(b, h) (((b) * 2 + (h)) * 16384)
#define G_SB(b, h) ((4 + (b) * 2 + (h)) * 16384)
#define G_STAGE(bufoff, gp, voff) do { const bf16_t* gp_ = (gp); glds16(gp_ + (voff)[0], ldsw + (bufoff)); glds16(gp_ + (voff)[1], ldsw + (bufoff) + 8192); } while (0)
#define G_A0(kt) (Ap + (long)(kt) * ksa)
#define G_A1(kt) (Ap + hA + (long)(kt) * ksa)
#define G_B0(kt) (Bp + (long)(kt) * ksb)
#define G_B1(kt) (Bp + hB + (long)(kt) * ksb)
#define G_LDA(dst, b, h) do { _Pragma("unroll") for (int m = 0; m < 4; ++m) _Pragma("unroll") for (int k = 0; k < 2; ++k) dst[m][k] = *(const LAS bf16x8*)(shm + G_SA(b, h) + aoff + m * 2048 + k * 1024); } while (0)
#define G_LDB(dst, b, h) do { _Pragma("unroll") for (int n = 0; n < 2; ++n) _Pragma("unroll") for (int k = 0; k < 2; ++k) dst[n][k] = *(const LAS bf16x8*)(shm + G_SB(b, h) + boff + n * 2048 + k * 1024); } while (0)
#define G_MMA(ai, bj, A_, B_) do { __builtin_amdgcn_s_setprio(1); _Pragma("unroll") for (int m = 0; m < 4; ++m) _Pragma("unroll") for (int n = 0; n < 2; ++n) _Pragma("unroll") for (int k = 0; k < 2; ++k) \
    acc[ai][bj][m][n] = MFMA16(B_[n][k], A_[m][k], acc[ai][bj][m][n]); __builtin_amdgcn_s_setprio(0); } while (0)
#define G_WAIT_V(n) asm volatile("s_waitcnt vmcnt(" #n ")" ::: "memory")
#define G_WAIT_L(n) asm volatile("s_waitcnt lgkmcnt(" #n ")" ::: "memory")
#define G_BAR __builtin_amdgcn_s_barrier()
#define G_SCHED __builtin_amdgcn_sched_barrier(0)
  G_WAIT_V(0);
  if (!pre) {
    G_STAGE(G_SB(0, 0), G_B0(0), voffB); G_STAGE(G_SA(0, 0), G_A0(0), voffA); G_STAGE(G_SB(0, 1), G_B1(0), voffB); G_STAGE(G_SA(0, 1), G_A1(0), voffA);
    if (wr == 1) G_BAR;
    G_WAIT_V(4); G_BAR;
    G_STAGE(G_SB(1, 0), G_B0(1), voffB); G_STAGE(G_SA(1, 0), G_A0(1), voffA); G_STAGE(G_SB(1, 1), G_B1(1), voffB);
    G_WAIT_V(6); G_BAR;
  } else {
    if (wr == 1) G_BAR;
    G_BAR; G_BAR;
  }
#pragma unroll 1
  for (int t = 0; t < nt - 2; t += 2) {
    G_LDB(B0, 0, 0); G_SCHED; G_LDA(At, 0, 0); G_STAGE(G_SA(1, 1), G_A1(t + 1), voffA);
    G_WAIT_L(8); G_BAR; G_WAIT_L(0); G_MMA(0, 0, At, B0); G_BAR; G_SCHED;
    G_LDB(B1, 0, 1); G_STAGE(G_SB(0, 0), G_B0(t + 2), voffB);
    G_BAR; G_WAIT_L(0); G_MMA(0, 1, At, B1); G_BAR;
    G_LDA(At, 0, 1); G_STAGE(G_SA(0, 0), G_A0(t + 2), voffA);
    G_BAR; G_WAIT_L(0); G_MMA(1, 0, At, B0); G_BAR; G_SCHED;
    G_STAGE(G_SB(0, 1), G_B1(t + 2), voffB);
    G_WAIT_V(6); G_BAR; G_MMA(1, 1, At, B1); G_BAR;
    G_LDB(B0, 1, 0); G_SCHED; G_LDA(At, 1, 0); G_STAGE(G_SA(0, 1), G_A1(t + 2), voffA);
    G_WAIT_L(8); G_BAR; G_WAIT_L(0); G_MMA(0, 0, At, B0); G_BAR; G_SCHED;
    G_LDB(B1, 1, 1); G_STAGE(G_SB(1, 0), G_B0(t + 3), voffB);
    G_BAR; G_WAIT_L(0); G_MMA(0, 1, At, B1); G_BAR;
    G_LDA(At, 1, 1); G_STAGE(G_SA(1, 0), G_A0(t + 3), voffA);
    G_BAR; G_WAIT_L(0); G_MMA(1, 0, At, B0); G_BAR; G_SCHED;
    G_STAGE(G_SB(1, 1), G_B1(t + 3), voffB);
    G_WAIT_V(6); G_BAR; G_MMA(1, 1, At, B1); G_BAR;
  }
  { G_LDB(B0, 0, 0); G_LDA(At, 0, 0); G_STAGE(G_SA(1, 1), G_A1(nt - 1), voffA);
    G_BAR; G_WAIT_L(0); G_MMA(0, 0, At, B0); G_BAR;
    G_LDB(B1, 0, 1); G_BAR; G_WAIT_L(0); G_MMA(0, 1, At, B1); G_BAR;
    G_LDA(At, 0, 1); G_WAIT_V(4); G_BAR; G_WAIT_L(0); G_MMA(1, 0, At, B0); G_MMA(1, 1, At, B1); G_BAR; }
  { G_LDB(B0, 1, 0); G_LDA(At, 1, 0); G_WAIT_V(2); G_BAR; G_WAIT_L(0); G_MMA(0, 0, At, B0); G_BAR;
    G_LDB(B1, 1, 1); G_WAIT_V(0); G_BAR; G_WAIT_L(0); G_MMA(0, 1, At, B1); G_BAR;
    G_LDA(At, 1, 1); G_BAR; G_WAIT_L(0); G_MMA(1, 0, At, B0); G_MMA(1, 1, At, B1); G_BAR; }
  if (wr == 0) G_BAR;
  asm volatile("" ::: "memory");
}

DI void gemm_prefetch(const bf16_t* Ap, long lda, long ksa, const bf16_t* Bp, long ldb, long ksb, LAS unsigned char* shm) {
  int tid_ = threadIdx.x; asm volatile("" : "+v"(tid_)); const int tid = tid_, wid = __builtin_amdgcn_readfirstlane(tid >> 6);
  int voffA[2], voffB[2];
#pragma unroll
  for (int i = 0; i < 2; ++i) { int R, C; stage_rc(tid * 16 + i * 8192, R, C); voffA[i] = R * (int)lda + C; voffB[i] = R * (int)ldb + C; }
  LAS unsigned char* ldsw = shm + wid * 1024;
  const long hA = 128 * lda, hB = 128 * ldb;
  G_STAGE(G_SB(0, 0), G_B0(0), voffB); G_STAGE(G_SA(0, 0), G_A0(0), voffA); G_STAGE(G_SB(0, 1), G_B1(0), voffB); G_STAGE(G_SA(0, 1), G_A1(0), voffA);
  G_STAGE(G_SB(1, 0), G_B0(1), voffB); G_STAGE(G_SA(1, 0), G_A0(1), voffA); G_STAGE(G_SB(1, 1), G_B1(1), voffB);
}

struct GUnit { const bf16_t* Ap; const bf16_t* Bp; int lda, ldb; long ksa, ksb; int nt, pm, pn, permB; };
#define G_STAGE2(bufoff, gp, v0, v1) do { const bf16_t* gp_ = (gp); glds16(gp_ + (v0), ldsw + (bufoff)); glds16(gp_ + (v1), ldsw + (bufoff) + 8192); } while (0)
template <class Seq>
DI void gemm_stream(const Seq& seq, LAS unsigned char* shm, const bool pre = false, const bool has_tail = false, const GUnit tail = GUnit{}) {
  int tid_ = threadIdx.x; asm volatile("" : "+v"(tid_)); const int tid = tid_, wid = __builtin_amdgcn_readfirstlane(tid >> 6), lane = tid & 63, wr = wid >> 2, wc = wid & 3, fr = lane & 15, fq = lane >> 4;
  int R0, C0, R1, C1; stage_rc(tid * 16, R0, C0); stage_rc(tid * 16 + 8192, R1, C1);
  const int aoff = lds_byte(wr * 64 + fr, fq * 8), boff = lds_byte(wc * 32 + fr, fq * 8);
  LAS unsigned char* ldsw = shm + wid * 1024;
  GUnit cur, nxt;
  if (!seq.get(0, cur)) return;
  f32x4 acc[2][2][4][2];
#pragma unroll
  for (int ai = 0; ai < 2; ++ai)
#pragma unroll
    for (int bj = 0; bj < 2; ++bj)
#pragma unroll
      for (int m = 0; m < 4; ++m)
#pragma unroll
        for (int n = 0; n < 2; ++n) acc[ai][bj][m][n] = (f32x4){0.f, 0.f, 0.f, 0.f};
  bf16x8 At[4][2], B0[2][2], B1[2][2];
  const int P0 = (R0 & ~31) + 8 * ((R0 & 15) >> 2) + 4 * ((R0 >> 4) & 1) + (R0 & 3), P1 = (R1 & ~31) + 8 * ((R1 & 15) >> 2) + 4 * ((R1 >> 4) & 1) + (R1 & 3);
  int va0 = R0 * cur.lda + C0, va1 = R1 * cur.lda + C1, vb0 = (cur.permB ? P0 : R0) * cur.ldb + C0, vb1 = (cur.permB ? P1 : R1) * cur.ldb + C1;
  G_WAIT_V(0);
  if (pre) { if (wr == 1) G_BAR; G_BAR; G_BAR; }
  else {
    const bf16_t* Ap = cur.Ap; const bf16_t* Bp = cur.Bp; const long hA = 128L * cur.lda, hB = 128L * cur.ldb;
    G_STAGE2(G_SB(0, 0), Bp, vb0, vb1); G_STAGE2(G_SB(0, 1), Bp + hB, vb0, vb1); G_STAGE2(G_SA(0, 0), Ap, va0, va1); G_STAGE2(G_SA(0, 1), Ap + hA, va0, va1);
    if (wr == 1) G_BAR;
    G_WAIT_V(2); G_BAR;
    G_STAGE2(G_SB(1, 0), Bp + cur.ksb, vb0, vb1); G_STAGE2(G_SA(1, 0), Ap + cur.ksa, va0, va1); G_STAGE2(G_SB(1, 1), Bp + hB + cur.ksb, vb0, vb1);
    G_WAIT_V(6); G_BAR;
  }
  for (int ui = 0;; ++ui) {
    const bool has_next = seq.get(ui + 1, nxt);
    if (!has_next) nxt = has_tail ? tail : cur;
    const int na0 = R0 * nxt.lda + C0, na1 = R1 * nxt.lda + C1, nb0 = (nxt.permB ? P0 : R0) * nxt.ldb + C0, nb1 = (nxt.permB ? P1 : R1) * nxt.ldb + C1;
    const long hA = 128L * cur.lda, hB = 128L * cur.ldb, nhA = 128L * nxt.lda, nhB = 128L * nxt.ldb;
    const int nt = cur.nt;
#pragma unroll 1
    for (int t = 0; t < nt; t += 2) {
      const bool last = t == nt - 2;
      const bf16_t* a1 = cur.Ap + (long)(t + 1) * cur.ksa;
      const bf16_t* a2 = last ? nxt.Ap : cur.Ap + (long)(t + 2) * cur.ksa; const bf16_t* b2 = last ? nxt.Bp : cur.Bp + (long)(t + 2) * cur.ksb;
      const bf16_t* a3 = a2 + (last ? nxt.ksa : cur.ksa); const bf16_t* b3 = b2 + (last ? nxt.ksb : cur.ksb);
      const long h2A = last ? nhA : hA, h2B = last ? nhB : hB;
      const int xa0 = last ? na0 : va0, xa1 = last ? na1 : va1, xb0 = last ? nb0 : vb0, xb1 = last ? nb1 : vb1;
      G_LDB(B0, 0, 0); G_LDB(B1, 0, 1); G_SCHED; G_LDA(At, 0, 0); G_STAGE2(G_SA(1, 1), a1 + hA, va0, va1);
      G_WAIT_V(8); G_WAIT_L(0); G_BAR; G_MMA(0, 0, At, B0); G_MMA(0, 1, At, B1); G_BAR; G_SCHED;
      G_LDA(At, 0, 1); G_STAGE2(G_SB(0, 0), b2, xb0, xb1); G_STAGE2(G_SB(0, 1), b2 + h2B, xb0, xb1); G_STAGE2(G_SA(0, 0), a2, xa0, xa1);
      G_WAIT_V(8); G_WAIT_L(0); G_BAR; G_MMA(1, 0, At, B0); G_MMA(1, 1, At, B1); G_BAR; G_SCHED;
      G_LDB(B0, 1, 0); G_LDB(B1, 1, 1); G_SCHED; G_LDA(At, 1, 0); G_STAGE2(G_SA(0, 1), a2 + h2A, xa0, xa1);
      G_WAIT_V(8); G_WAIT_L(0); G_BAR; G_MMA(0, 0, At, B0); G_MMA(0, 1, At, B1); G_BAR; G_SCHED;
      G_LDA(At, 1, 1); G_STAGE2(G_SB(1, 0), b3, xb0, xb1); G_STAGE2(G_SB(1, 1), b3 + h2B, xb0, xb1); G_STAGE2(G_SA(1, 0), a3, xa0, xa1);
      G_WAIT_V(8); G_WAIT_L(0); G_BAR; G_MMA(1, 0, At, B0); G_MMA(1, 1, At, B1); G_BAR; G_SCHED;
    }
    if (wr == 0) G_BAR;
    asm volatile("" ::: "memory");
    seq.epi(acc, cur);
    if (!has_next) break;
#pragma unroll
    for (int ai = 0; ai < 2; ++ai)
#pragma unroll
      for (int bj = 0; bj < 2; ++bj)
#pragma unroll
        for (int m = 0; m < 4; ++m)
#pragma unroll
          for (int n = 0; n < 2; ++n) acc[ai][bj][m][n] = (f32x4){0.f, 0.f, 0.f, 0.f};
    cur = nxt; va0 = na0; va1 = na1; vb0 = nb0; vb1 = nb1;
    if (wr == 1) G_BAR;
  }
  G_WAIT_V(0);
  __syncthreads();
}

DI bool tile_map(int i, int nM, int nN, int& pm, int& pn) {
  const int G = gridDim.x, c = blockIdx.x;
  if ((G & 7) == 0 && (nM & 63) == 0) {
    const int x = c & 7, loc = c >> 3, per = G >> 3, q = i * per + loc, total = (nM >> 3) * nN;
    if (q >= total) return false;
    const int g = q / (8 * nN), r = q % (8 * nN);
    pm = 8 * (g * 8 + (r & 7)) + x; pn = r >> 3; return true;
  }
  const long L = (long)i * G + c; if (L >= (long)nM * nN) return false;
  pm = (int)(L / nN); pn = (int)(L % nN); return true;
}

template <int MODE>
DI void conv_item(const float* src, const float* src2, const float* rs, bf16_t* dst, int K, int Nsrc, int nblk, LAS float* scr, int item, int lane) {
  const int kb = item / nblk, nb = item % nblk, k0 = 64 * kb, n0 = 32 * nb;
  const int n = n0 + (lane & 31);
  int col = n; float cs = 1.f; const float* s = src;
  if (MODE == 0) {
    if (n < 1024) { const int head = n >> 7, pp = n & 127, half = (pp >> 4) & 1, jj = pp >> 5, i = pp & 15; col = head * 128 + half * 64 + jj * 16 + i; if (n >= 512) cs = 0.08838834764831845f; }
    else if (n >= 3072 && n < 4096) { const int c = (n - 3072) & 255, base = n - c; col = base + 64 * ((c >> 5) & 3) + 32 * (c >> 7) + 8 * ((c & 15) >> 2) + 4 * ((c >> 4) & 1) + (c & 3); }
    else if ((n >= 2048 && n < 3072) || n >= 4608) { const int rho = n & 31; col = (n & ~31) + 8 * ((rho & 15) >> 2) + 4 * (rho >> 4) + (rho & 3); }
  } else if (MODE == 3) {
    const int rho = n & 31; col = (n & ~31) + 8 * ((rho & 15) >> 2) + 4 * (rho >> 4) + (rho & 3);
  } else if (MODE == 1) {
    const int c = n & 255, r7 = c & 127, rho = r7 & 31; col = (n >> 8) * 128 + (r7 & ~31) + 8 * ((rho & 15) >> 2) + 4 * (rho >> 4) + (rho & 3); if (c >> 7) s = src2;
  }
  const float* sp = s + (long)(k0 + (lane >> 5)) * Nsrc + col;
#pragma unroll 8
  for (int i = 0; i < 32; ++i) {
    const int kk = 2 * i + (lane >> 5);
    float w = sp[(long)(2 * i) * Nsrc] * cs;
    if (rs) w *= rs[k0 + kk];
    scr[kk * 33 + (lane & 31)] = w;
  }
  asm volatile("s_waitcnt lgkmcnt(0)" ::: "memory");
  const int c = lane & 7;
#pragma unroll
  for (int j = 0; j < 4; ++j) {
    const int nn = (lane >> 3) + 8 * j; const LAS float* q = scr + (8 * c) * 33 + nn;
    u32x4 o; o.x = pk2(q[0], q[33]); o.y = pk2(q[2 * 33], q[3 * 33]); o.z = pk2(q[4 * 33], q[5 * 33]); o.w = pk2(q[6 * 33], q[7 * 33]);
    *(u32x4*)(dst + (long)(n0 + nn) * K + k0 + 8 * c) = o;
  }
  asm volatile("s_waitcnt lgkmcnt(0)" ::: "memory");
}

DI void phase0(const Params& p, LAS unsigned char* shm, int part = 7) {
  unsigned char* ws = p.ws;
  const long gtid = (long)blockIdx.x * NTHREADS + threadIdx.x, nthr = (long)gridDim.x * NTHREADS;
  const int lane = threadIdx.x & 63, wv = threadIdx.x >> 6, gw = blockIdx.x * 8 + wv, ngw = gridDim.x * 8;
  if (part & 1) {
    bf16_t* xb = (bf16_t*)((unsigned char*)p.out + 64 * MiB);
    float* rstd1 = (float*)(ws + OFF_RSTD1);
    for (int r0 = gw * 4; r0 < T_TOK; r0 += ngw * 4) {
      f32x4 v[4][4];
#pragma unroll
      for (int rr = 0; rr < 4; ++rr) {
        const f32x4* xr = (const f32x4*)(p.x + (long)(r0 + rr) * DM) + lane;
#pragma unroll
        for (int j = 0; j < 4; ++j) v[rr][j] = xr[64 * j];
      }
#pragma unroll
      for (int rr = 0; rr < 4; ++rr) {
        float s = 0.f;
#pragma unroll
        for (int j = 0; j < 4; ++j) s += v[rr][j][0] * v[rr][j][0] + v[rr][j][1] * v[rr][j][1] + v[rr][j][2] * v[rr][j][2] + v[rr][j][3] * v[rr][j][3];
#pragma unroll
        for (int o = 1; o < 64; o <<= 1) s += __shfl_xor(s, o);
        if (lane == 0) rstd1[r0 + rr] = 1.0f / sqrtf(s * (1.0f / DM) + 1e-6f);
        u32x2* o8 = (u32x2*)(xb + (long)(r0 + rr) * DM) + lane;
#pragma unroll
        for (int j = 0; j < 4; ++j) o8[64 * j] = pk4(v[rr][j]);
      }
    }
  }
  if (part & 2) {
    LAS float* scr = (LAS float*)shm + wv * (64 * 33);
    constexpr int I0 = 16 * 208, I1 = 16 * 32, I2 = 8 * 32, I3 = 16 * 32, I4 = 16 * 176, I5 = 44 * 32;
    for (int it = gw; it < I0 + I1 + I2 + I3 + I4 + I5; it += ngw) {
      int r = it;
      if (r < I0) { conv_item<0>(p.w_in, nullptr, p.norm1_w, (bf16_t*)(ws + OFF_WIN), 1024, NCOL, 208, scr, r, lane); continue; } r -= I0;
      if (r < I1) { conv_item<3>(p.w_ret_out, nullptr, nullptr, (bf16_t*)(ws + OFF_WRO), 1024, 1024, 32, scr, r, lane); continue; } r -= I1;
      if (r < I2) { conv_item<3>(p.w_moba_out, nullptr, nullptr, (bf16_t*)(ws + OFF_WMO), 512, 1024, 32, scr, r, lane); continue; } r -= I2;
      if (r < I3) { conv_item<3>(p.w_o, nullptr, nullptr, (bf16_t*)(ws + OFF_WO), 1024, 1024, 32, scr, r, lane); continue; } r -= I3;
      if (r < I4) { conv_item<1>(p.w_gate, p.w_up, p.norm2_w, (bf16_t*)(ws + OFF_WGU), 1024, FH, 176, scr, r, lane); continue; } r -= I4;
      conv_item<2>(p.w_down, nullptr, nullptr, (bf16_t*)(ws + OFF_WD), FH, 1024, 32, scr, r, lane);
    }
  }
  if (part & 4) {
    float* cosT = (float*)(ws + OFF_COS); float* sinT = (float*)(ws + OFF_SIN);
    for (long idx = gtid; idx < (long)SEQ * 64; idx += nthr) {
      const int pos = (int)(idx >> 6), j = (int)(idx & 63);
      const float inv = exp2f(-(float)j * (13.287712379549449f / 64.0f));
      const float ang = (float)pos * inv;
      const double rev = (double)ang * 0.15915494309189535;
      const float fr = (float)(rev - __builtin_rint(rev));
      cosT[idx] = __builtin_amdgcn_cosf(fr); sinT[idx] = __builtin_amdgcn_sinf(fr);
    }
  }
  if (blockIdx.x == 0 && threadIdx.x < 64) {
    float a = fabsf(p.q_norm_w[threadIdx.x]), b = fabsf(p.k_norm_w[threadIdx.x]);
#pragma unroll
    for (int o = 1; o < 64; o <<= 1) { a = fmaxf(a, __shfl_xor(a, o)); b = fmaxf(b, __shfl_xor(b, o)); }
    if (threadIdx.x == 0) ((float*)(ws + OFF_SC))[0] = 8.0f * a * b * 1.01f;
  }
}

template <int REG>
DI void epi_inproj(const Params& p, f32x4 (&acc)[2][2][4][2], int pm, int pn, LAS unsigned char* shm) {
  unsigned char* ws = p.ws;
  int tid_ = threadIdx.x; asm volatile("" : "+v"(tid_)); const int tid = tid_, wid = tid >> 6, lane = tid & 63, wr = wid >> 2, wc = wid & 3, fr = lane & 15, fq = lane >> 4;
  const int b = pm >> 5, blk = pm & 31, t0 = blk * 256, T0 = pm * 256;
  const float* rstd1 = (const float*)(ws + OFF_RSTD1);
  float rsr[2][4];
  if (REG != 1) {
#pragma unroll
    for (int ai = 0; ai < 2; ++ai)
#pragma unroll
      for (int m = 0; m < 4; ++m) rsr[ai][m] = rstd1[T0 + 128 * ai + 64 * wr + 16 * m + fr];
  }
  if (REG == 0) {
    const bool isk = pn >= 2;
    const float* cosT = (const float*)(ws + OFF_COS); const float* sinT = (const float*)(ws + OFF_SIN);
    bf16_t* dstb = (bf16_t*)(ws + (isk ? OFF_KR : OFF_QR));
    bf16_t* krt = (bf16_t*)(ws + OFF_KRT);
#pragma unroll
    for (int ai = 0; ai < 2; ++ai)
#pragma unroll
      for (int m = 0; m < 4; ++m) { asm volatile("" ::: "memory");
        const int r = 128 * ai + 64 * wr + 16 * m + fr, t = t0 + r;
        const float rs = rsr[ai][m];
        const f32x4 cs = *(const f32x4*)(cosT + t * 64 + 16 * wc + 4 * fq), sn = *(const f32x4*)(sinT + t * 64 + 16 * wc + 4 * fq);
#pragma unroll
        for (int bj = 0; bj < 2; ++bj) {
          const int h = 2 * (pn & 1) + bj;
          const float sc = fast_exp2((isk ? -1.f : 1.f) * (float)(t & 127) * lg2gamma(h)) * rs;
          const f32x4 x1 = acc[ai][bj][m][0] * sc, x2 = acc[ai][bj][m][1] * sc;
          const f32x4 y1 = x1 * cs - x2 * sn, y2 = x2 * cs + x1 * sn;
          const int d = 16 * wc + 4 * fq;
          const int tl2 = t & 127, r32 = tl2 & 31;
          const int frag = isk ? (((tl2 >> 5) * 2 + ((r32 >> 2) & 1)) * 4 + (d >> 5)) : ((tl2 >> 4) * 4 + (d >> 5));
          const int frl = isk ? ((r32 >> 3) * 4 + (r32 & 3)) : (tl2 & 15);
          bf16_t* dst = dstb + ((long)((b * 4 + h) * 64 + (t >> 7))) * 16384 + (frag * 64 + ((d >> 3) & 3) * 16 + frl) * 8 + (d & 7);
          const u32x2 o1 = pk4(y1), o2 = pk4(y2);
          *(u32x2*)dst = o1; *(u32x2*)(dst + 2 * 512) = o2;
          if (isk) {
            LAS unsigned char* tb = shm + 135168 + wid * 1024;
            LAS bf16_t* w1 = (LAS bf16_t*)(tb + (4 * fq) * 32 + fr * 2);
            w1[0] = (bf16_t)(o1.x & 0xffff); w1[16] = (bf16_t)(o1.x >> 16); w1[32] = (bf16_t)(o1.y & 0xffff); w1[48] = (bf16_t)(o1.y >> 16);
            LAS bf16_t* w2 = w1 + 16 * 16;
            w2[0] = (bf16_t)(o2.x & 0xffff); w2[16] = (bf16_t)(o2.x >> 16); w2[32] = (bf16_t)(o2.y & 0xffff); w2[48] = (bf16_t)(o2.y >> 16);
            asm volatile("s_waitcnt lgkmcnt(0)" ::: "memory");
            const int dl = lane >> 1, th = lane & 1;
            const u32x4 kv = *(const LAS u32x4*)(tb + dl * 32 + th * 16);
            asm volatile("" ::: "memory");
            const int dd = dl < 16 ? 16 * wc + dl : 48 + 16 * wc + dl;
            const int tb0 = t0 + 128 * ai + 64 * wr + 16 * m + 8 * th, tl = tb0 & 127;
            *(u32x4*)(krt + ((long)((b * 4 + h) * 64 + (tb0 >> 7))) * 16384 + (((dd >> 4) * 4 + (tl >> 5)) * 64 + ((tl >> 3) & 3) * 16 + (dd & 15)) * 8) = kv;
          }
        }
      }
  } else if (REG == 1) {
    const bool isr = pn < 8;
    f32x4 rs4[2][2];
#pragma unroll
    for (int bj = 0; bj < 2; ++bj)
#pragma unroll
      for (int n = 0; n < 2; ++n) rs4[bj][n] = *(const f32x4*)(rstd1 + T0 + 128 * bj + 32 * wc + 8 * fq + 4 * n);
#pragma unroll
    for (int bj = 0; bj < 2; ++bj) {
      const int cB = 128 * bj + 32 * wc + 8 * fq;
#pragma unroll
      for (int ai = 0; ai < 2; ++ai)
#pragma unroll
        for (int m = 0; m < 4; ++m) { asm volatile("" ::: "memory");
          const int rA = 128 * ai + 64 * wr + 16 * m + fr;
          bf16_t* dst;
          if (isr) { const int tl = cB & 127;
            dst = (bf16_t*)(ws + OFF_VRT) + ((long)((b * 4 + (pn - 4)) * 64 + 2 * blk + (cB >> 7))) * 32768 + (((rA >> 4) * 4 + (tl >> 5)) * 64 + ((tl >> 3) & 3) * 16 + (rA & 15)) * 8; }
          else dst = (bf16_t*)(ws + OFF_MVT) + ((long)(((b * 8 + (pn - 16) * 4 + (rA >> 6)) * 32 + blk) * 64 + (rA & 63))) * 256 + cB;
          const u32x2 h0 = pk4(acc[ai][bj][m][0] * rs4[bj][0]), h1 = pk4(acc[ai][bj][m][1] * rs4[bj][1]);
          *(u32x4*)dst = (u32x4){h0.x, h0.y, h1.x, h1.y};
        }
    }
  } else if (REG == 2) {
    bf16_t* dstb; int cb;
    if (pn < 12) { dstb = (bf16_t*)(ws + OFF_G); cb = (pn - 8) * 256; }
    else if (pn < 22) { dstb = (bf16_t*)(ws + OFF_GA); cb = (pn - 18) * 256; }
    else { dstb = (bf16_t*)(ws + OFF_GB); cb = (pn - 22) * 256; }
    const bool silu = pn < 12;
#pragma unroll
    for (int ai = 0; ai < 2; ++ai)
#pragma unroll
      for (int m = 0; m < 4; ++m) { asm volatile("" ::: "memory");
        const int r = 128 * ai + 64 * wr + 16 * m + fr;
        const float rs = rsr[ai][m];
#pragma unroll
        for (int bj = 0; bj < 2; ++bj) {
          u32x2 h[2];
#pragma unroll
          for (int n = 0; n < 2; ++n) {
            f32x4 v = acc[ai][bj][m][n] * rs, o;
#pragma unroll
            for (int j = 0; j < 4; ++j) { const float sg = sigmoidf_(v[j]); o[j] = silu ? v[j] * sg : sg; }
            h[n] = pk4(o);
          }
          *(u32x4*)(dstb + (long)(T0 + r) * 1024 + cb + 128 * bj + 32 * wc + 8 * fq) = (u32x4){h[0].x, h[0].y, h[1].x, h[1].y};
        }
      }
  } else {
    const bool isk = pn >= 14;
    const float* nw = isk ? p.k_norm_w : p.q_norm_w;
    bf16_t* dstb = (bf16_t*)(ws + (isk ? OFF_MK : OFF_MQ));
    const int hh = (pn & 1) * 4 + wc;
    f32x4 w4[2][2], cs4[2][2];
#pragma unroll
    for (int bj = 0; bj < 2; ++bj)
#pragma unroll
      for (int n = 0; n < 2; ++n) { w4[bj][n] = *(const f32x4*)(nw + 32 * bj + 8 * fq + 4 * n); cs4[bj][n] = (f32x4){0.f, 0.f, 0.f, 0.f}; }
#pragma unroll
    for (int ai = 0; ai < 2; ++ai)
#pragma unroll
      for (int m = 0; m < 4; ++m) { asm volatile("" ::: "memory");
        const int r = 128 * ai + 64 * wr + 16 * m + fr, t = t0 + r;
        const float rs = rsr[ai][m];
        f32x4 v[2][2]; float ss = 0.f;
#pragma unroll
        for (int bj = 0; bj < 2; ++bj)
#pragma unroll
          for (int n = 0; n < 2; ++n) { v[bj][n] = acc[ai][bj][m][n] * rs; ss += v[bj][n][0] * v[bj][n][0] + v[bj][n][1] * v[bj][n][1] + v[bj][n][2] * v[bj][n][2] + v[bj][n][3] * v[bj][n][3]; }
        ss += __shfl_xor(ss, 16); ss += __shfl_xor(ss, 32);
        const float rn = __builtin_amdgcn_rsqf(ss * (1.0f / 64.0f) + 1e-6f) * (isk ? 1.0f : 0.125f * 1.4426950408889634f);
        bf16_t* dst = dstb + ((long)((b * 8 + hh) * SEQ + t)) * 64 + 8 * fq;
#pragma unroll
        for (int bj = 0; bj < 2; ++bj) {
          const f32x4 o0 = v[bj][0] * rn * w4[bj][0], o1 = v[bj][1] * rn * w4[bj][1]; cs4[bj][0] += o0; cs4[bj][1] += o1;
          const u32x2 h0 = pk4(o0), h1 = pk4(o1);
          *(u32x4*)(dst + 32 * bj) = (u32x4){h0.x, h0.y, h1.x, h1.y};
        }
      }
    if (isk) {
      LAS float* red = (LAS float*)(shm + 131072);
#pragma unroll
      for (int bj = 0; bj < 2; ++bj)
#pragma unroll
        for (int n = 0; n < 2; ++n)
#pragma unroll
          for (int j = 0; j < 4; ++j) {
            float s = cs4[bj][n][j];
            s += __shfl_xor(s, 1); s += __shfl_xor(s, 2); s += __shfl_xor(s, 4); s += __shfl_xor(s, 8);
            if (fr == 0) red[wr * 256 + wc * 64 + 32 * bj + 8 * fq + 4 * n + j] = s;
          }
      __syncthreads();
      if (tid < 256) {
        float* kbar = (float*)(ws + OFF_KBAR);
        kbar[((long)((b * 8 + (pn & 1) * 4 + (tid >> 6)) * 32 + blk)) * 64 + (tid & 63)] = (red[tid] + red[256 + tid]) * (1.0f / 256.0f);
      }
      __syncthreads();
    }
  }
}

template <int REG>
struct SeqInproj {
  const Params& p; const bf16_t* xb; const bf16_t* W; LAS unsigned char* shm;
  static constexpr int NN = REG == 0 ? 4 : (REG == 1 ? 6 : (REG == 2 ? 12 : 4));
  DI bool get(int i, GUnit& u) const {
    int pm, ix;
    if (!tile_map(i, 128, NN, pm, ix)) return false;
    const int pn = REG == 0 ? ix : (REG == 1 ? (ix < 4 ? 4 + ix : 12 + ix) : (REG == 2 ? (ix < 4 ? 8 + ix : 14 + ix) : 12 + ix));
    const bf16_t* a = xb + (long)pm * 256 * DM; const bf16_t* b = W + (long)pn * 256 * DM;
    u.Ap = REG == 1 ? b : a; u.Bp = REG == 1 ? a : b; u.lda = DM; u.ldb = DM; u.ksa = 64; u.ksb = 64; u.nt = 16; u.pm = pm; u.pn = pn; u.permB = REG == 1;
    return true;
  }
  DI void epi(f32x4 (&acc)[2][2][4][2], const GUnit& u) const { epi_inproj<REG>(p, acc, u.pm, u.pn, shm); }
};
template <int REG>
DI void phase1_region(const Params& p, LAS unsigned char* shm) {
  const SeqInproj<REG> seq{p, (const bf16_t*)((unsigned char*)p.out + 64 * MiB), (const bf16_t*)(p.ws + OFF_WIN), shm};
  gemm_stream(seq, shm);
}
DI void phase1(const Params& p, LAS unsigned char* shm) {
  const bf16_t* xb = (const bf16_t*)((unsigned char*)p.out + 64 * MiB); const bf16_t* W = (const bf16_t*)(p.ws + OFF_WIN);
  bool pre = false;
  { const SeqInproj<2> s{p, xb, W, shm}; const SeqInproj<1> sn{p, xb, W, shm}; GUnit t, t0; const bool h = s.get(0, t0), hn = sn.get(0, t); gemm_stream(s, shm, pre, h && hn, t); pre = h && hn; }
  { const SeqInproj<1> s{p, xb, W, shm}; const SeqInproj<0> sn{p, xb, W, shm}; GUnit t, t0; const bool h = s.get(0, t0), hn = sn.get(0, t); gemm_stream(s, shm, pre, h && hn, t); pre = h && hn; }
  { const SeqInproj<0> s{p, xb, W, shm}; const SeqInproj<3> sn{p, xb, W, shm}; GUnit t, t0; const bool h = s.get(0, t0), hn = sn.get(0, t); gemm_stream(s, shm, pre, h && hn, t); pre = h && hn; }
  { const SeqInproj<3> s{p, xb, W, shm}; gemm_stream(s, shm, pre); }
}

DI void ret_scan(const Params& p, LAS unsigned char* shm) {
  unsigned char* ws = p.ws;
  int tid_ = threadIdx.x; asm volatile("" : "+v"(tid_)); const int tid = tid_, wid = tid >> 6, lane = tid & 63, fr = lane & 15, fq = lane >> 4;
  const bf16_t* Vrt = (const bf16_t*)(ws + OFF_VRT); const bf16_t* Krt = (const bf16_t*)(ws + OFF_KRT);
  bf16_t* RT = (bf16_t*)p.out;
  LAS bf16_t* stg = (LAS bf16_t*)shm;
  for (int u0 = blockIdx.x; u0 < 256; u0 += gridDim.x) {
    int u = u0;
    if (gridDim.x == 256) { const int x = u0 & 7, m = u0 >> 3; u = (2 * x + (m >> 4)) * 16 + (m & 15); }
    const int bh = u >> 4, e0 = (u & 15) * 16, h = bh & 3;
    const float lg = lg2gamma(h), g128 = exp2f(128.f * lg), g127 = exp2f(127.f * lg);
    const bf16_t* vp = Vrt + (long)(bh * 64) * 32768 + (e0 >> 4) * 2048 + lane * 8;
    const bf16_t* kp = Krt + (long)(bh * 64) * 16384 + wid * 2048 + lane * 8;
    f32x4 st = {0.f, 0.f, 0.f, 0.f};
    bf16x8 vb[4][4], kb[4][4];
#pragma unroll
    for (int r = 0; r < 4; ++r)
#pragma unroll
      for (int ks = 0; ks < 4; ++ks) { vb[r][ks] = *(const bf16x8*)(vp + r * 32768 + ks * 512); kb[r][ks] = *(const bf16x8*)(kp + r * 16384 + ks * 512); }
#pragma unroll 1
    for (int c0 = 0; c0 < 64; c0 += 8) {
#pragma unroll
      for (int s = 0; s < 8; ++s) {
        const int r = s & 3, c = c0 + s;
        LAS bf16_t* sp = stg + (s * 16 + 4 * fq) * 136 + 16 * wid + fr;
        sp[0] = f2bf(st[0]); sp[136] = f2bf(st[1]); sp[272] = f2bf(st[2]); sp[408] = f2bf(st[3]);
        f32x4 uacc = {0.f, 0.f, 0.f, 0.f};
#pragma unroll
        for (int ks = 0; ks < 4; ++ks) uacc = MFMA16(vb[r][ks], kb[r][ks], uacc);
        st = st * g128 + uacc * g127;
        const int cn = c + 4 < 64 ? c + 4 : 63;
#pragma unroll
        for (int ks = 0; ks < 4; ++ks) { vb[r][ks] = *(const bf16x8*)(vp + cn * 32768 + ks * 512); kb[r][ks] = *(const bf16x8*)(kp + cn * 16384 + ks * 512); }
      }
      __syncthreads();
#pragma unroll
      for (int i = 0; i < 4; ++i) {
        const int pc = tid + i * NTHREADS, s = pc >> 8, ch = (pc >> 4) & 15, el = pc & 15;
        const u32x4 v = *(const LAS u32x4*)(stg + (s * 16 + el) * 136 + ch * 8);
        *(u32x4*)(RT + (long)(bh * 64 + c0 + s) * 32768 + ((((e0 >> 4) * 4 + (ch >> 2)) * 64 + (ch & 3) * 16 + el) * 8)) = v;
      }
      __syncthreads();
    }
  }
}

constexpr int MO_QS = 144;
constexpr int MO_OACC = 0, MO_L = 256 * 64 * 4, MO_CNT = MO_L + 1024, MO_LIST = MO_CNT + 128, MO_Q = MO_LIST + 32 * 256, MO_P = MO_Q + 256 * MO_QS, MO_KBAR = MO_P, MO_END = MO_P + 32768;
static_assert(MO_END <= LDS_BYTES, "moba lds");
DI int mo_oidx(int q, int d4) { return q * 64 + ((d4 ^ (q & 15)) << 2); }

DI void moba_loadkv(const bf16_t* Mk, const bf16_t* Mvt, long krow0, long vrow, int j, int w, int fr, int fq, bf16x8 (&kf)[2][2], bf16x8 (&vf)[8]) {
  const int prow = (fr >> 2) * 8 + (fr & 3);
  const bf16_t* kp = Mk + (krow0 + j * 256 + 32 * w + prow) * 64 + fq * 8;
  kf[0][0] = *(const bf16x8*)kp; kf[0][1] = *(const bf16x8*)(kp + 32); kf[1][0] = *(const bf16x8*)(kp + 256); kf[1][1] = *(const bf16x8*)(kp + 288);
  const bf16_t* vp = Mvt + vrow + ((long)j * 64 + (w & 3) * 16 + fr) * 256 + fq * 8;
#pragma unroll
  for (int ks = 0; ks < 8; ++ks) vf[ks] = *(const bf16x8*)(vp + ks * 32);
}

DI void moba_phase(const Params& p, LAS unsigned char* shm, int mode = 0) {
  const bool dry = mode != 0;
  unsigned char* ws = p.ws;
  int tid_ = threadIdx.x; asm volatile("" : "+v"(tid_)); const int tid = tid_, wid = __builtin_amdgcn_readfirstlane(tid >> 6), lane = tid & 63, fr = lane & 15, fq = lane >> 4;
  const bf16_t* Mk = (const bf16_t*)(ws + OFF_MK); const bf16_t* Mvt = (const bf16_t*)(ws + OFF_MVT);
  bf16_t* Mq = (bf16_t*)(ws + OFF_MQ);
  const float* kbarg = (const float*)(ws + OFF_KBAR);
  const float mb = ((const float*)(ws + OFF_SC))[0];
  const float c2 = mb * 1.4426950408889634f;
  LAS float* oacc = (LAS float*)(shm + MO_OACC); LAS float* lsl = (LAS float*)(shm + MO_L); LAS float* kb = (LAS float*)(shm + MO_KBAR);
  LAS int* cnt = (LAS int*)(shm + MO_CNT); LAS unsigned char* list = shm + MO_LIST; LAS unsigned char* Qs = shm + MO_Q; LAS unsigned char* Pb = shm + MO_P;
  const int dtw = wid & 3, ttw = wid >> 2;
  for (int u = blockIdx.x, it = 0; u < 1024; u += gridDim.x, ++it) {
    int blk = 31 - (u >> 5), bh = u & 31;
    if (gridDim.x == 256) {
      const int x = blockIdx.x & 7, m = blockIdx.x >> 3, m2 = (m + 16) & 31;
      bh = x + 8 * it; blk = it == 0 ? 31 - m : (it == 1 ? m : (it == 2 ? m2 : 31 - m2));
    }
    const long qbase = ((long)bh * SEQ + blk * 256) * 64;
    for (int i = tid; i < 256 * 64; i += NTHREADS) oacc[i] = 0.f;
    if (tid < 256) lsl[tid] = 0.f;
    if (tid < 32) cnt[tid] = 0;
    for (int i = tid; i < blk * 64; i += NTHREADS) kb[i] = kbarg[((long)bh * 32) * 64 + i];
    const int qt = tid >> 1, qh = tid & 1;
    u32x4 qw[4];
    {
      const u32x4* qp = (const u32x4*)(Mq + qbase + (long)qt * 64 + qh * 32);
#pragma unroll
      for (int i = 0; i < 4; ++i) { qw[i] = qp[i]; *(LAS u32x4*)(Qs + qt * MO_QS + qh * 64 + i * 16) = qw[i]; }
    }
    __syncthreads();
    if (blk > 0) {
      float q[32];
#pragma unroll
      for (int i = 0; i < 4; ++i) { const u32x4 w4 = qw[i]; q[8 * i] = __uint_as_float(w4.x << 16); q[8 * i + 1] = __uint_as_float(w4.x & 0xffff0000u); q[8 * i + 2] = __uint_as_float(w4.y << 16); q[8 * i + 3] = __uint_as_float(w4.y & 0xffff0000u);
        q[8 * i + 4] = __uint_as_float(w4.z << 16); q[8 * i + 5] = __uint_as_float(w4.z & 0xffff0000u); q[8 * i + 6] = __uint_as_float(w4.w << 16); q[8 * i + 7] = __uint_as_float(w4.w & 0xffff0000u); }
      float v0 = -3e38f, v1 = -3e38f, v2 = -3e38f; int i0 = -1, i1 = -1, i2 = -1;
      for (int j = 0; j < blk; ++j) {
        float g0 = 0.f, g1 = 0.f;
#pragma unroll
        for (int d = 0; d < 32; d += 8) { const f32x4 k4 = *(const LAS f32x4*)(kb + j * 64 + qh * 32 + d), k5 = *(const LAS f32x4*)(kb + j * 64 + qh * 32 + d + 4);
          g0 += q[d] * k4[0] + q[d + 1] * k4[1] + q[d + 2] * k4[2] + q[d + 3] * k4[3]; g1 += q[d + 4] * k5[0] + q[d + 5] * k5[1] + q[d + 6] * k5[2] + q[d + 7] * k5[3]; }
        float g = g0 + g1;
        g += __shfl_xor(g, 1);
        if (g > v0) { v2 = v1; i2 = i1; v1 = v0; i1 = i0; v0 = g; i0 = j; }
        else if (g > v1) { v2 = v1; i2 = i1; v1 = g; i1 = j; }
        else if (g > v2) { v2 = g; i2 = j; }
      }
      if (qh == 0) {
        if (i0 >= 0) { const int pz = atomicAdd((int*)(cnt + i0), 1); list[i0 * 256 + pz] = (unsigned char)qt; }
        if (i1 >= 0) { const int pz = atomicAdd((int*)(cnt + i1), 1); list[i1 * 256 + pz] = (unsigned char)qt; }
        if (i2 >= 0) { const int pz = atomicAdd((int*)(cnt + i2), 1); list[i2 * 256 + pz] = (unsigned char)qt; }
      }
    }
    __syncthreads();
    const long krow0 = (long)bh * SEQ, vrow = (long)bh * 64 * SEQ;
#define MO_BARRIER do { asm volatile("s_waitcnt lgkmcnt(0)" ::: "memory"); __builtin_amdgcn_s_barrier(); asm volatile("" ::: "memory"); } while (0)
    if (mode != 2) {
      if (wid >= 4) {
        const int sw = wid & 3, prow = (fr >> 2) * 8 + (fr & 3);
        bf16x8 kf[4][2], kn[4][2];
#pragma unroll
        for (int a = 0; a < 4; ++a) { kf[a][0] = (bf16x8){0, 0, 0, 0, 0, 0, 0, 0}; kf[a][1] = kf[a][0]; }
        int stepc = 0;
        auto ssteps = [&](const int j, auto ownc) {
          constexpr bool own = decltype(ownc)::value;
          const int n = j < 0 ? 0 : (own ? 256 : cnt[j]), ntile = (n + 15) >> 4;
          for (int s0 = 0; s0 < ntile; s0 += 2, ++stepc) {
            LAS unsigned char* pbuf = Pb + (stepc & 1) * 16384;
            if (!(mode & 4))
#pragma unroll
            for (int tt = 0; tt < 2; ++tt) {
              const int tile = s0 + tt;
              if (tile < ntile) {
                const int rem = n - tile * 16;
                const int qidx = own ? tile * 16 + fr : (int)list[j * 256 + tile * 16 + (fr < rem ? fr : 0)];
                const bf16x8 q0 = *(const LAS bf16x8*)(Qs + qidx * MO_QS + fq * 16), q1 = *(const LAS bf16x8*)(Qs + qidx * MO_QS + 64 + fq * 16);
#pragma unroll
                for (int g = 0; g < 2; ++g) {
                  f32x4 sv[2];
#pragma unroll
                  for (int par = 0; par < 2; ++par) { sv[par] = MFMA16(kf[g * 2 + par][0], q0, ((f32x4){0.f, 0.f, 0.f, 0.f})); sv[par] = MFMA16(kf[g * 2 + par][1], q1, sv[par]); }
                  float pv[2][4];
#pragma unroll
                  for (int par = 0; par < 2; ++par)
#pragma unroll
                    for (int i = 0; i < 4; ++i) {
                      float pe = fast_exp2(sv[par][i] - c2);
                      if (own) { const int key = 64 * sw + 32 * g + fq * 8 + 4 * par + i; if (key > qidx) pe = 0.f; }
                      pv[par][i] = pe;
                    }
                  u32x4 pw; pw.x = pk2(pv[0][0], pv[0][1]); pw.y = pk2(pv[0][2], pv[0][3]); pw.z = pk2(pv[1][0], pv[1][1]); pw.w = pk2(pv[1][2], pv[1][3]);
                  *(LAS u32x4*)(pbuf + tt * 8192 + (2 * sw + g) * 1024 + lane * 16) = pw;
                }
              }
            }
            MO_BARRIER;
          }
        };
        for (int j = -1; j < blk; ++j) {
          {
            const bf16_t* kp = Mk + (krow0 + (j + 1) * 256 + 64 * sw + prow) * 64 + fq * 8;
#pragma unroll
            for (int g = 0; g < 2; ++g)
#pragma unroll
              for (int par = 0; par < 2; ++par) { kn[g * 2 + par][0] = *(const bf16x8*)(kp + (32 * g + 4 * par) * 64); kn[g * 2 + par][1] = *(const bf16x8*)(kp + (32 * g + 4 * par) * 64 + 32); }
          }
          ssteps(j, std::false_type{});
#pragma unroll
          for (int a = 0; a < 4; ++a) { kf[a][0] = kn[a][0]; kf[a][1] = kn[a][1]; }
        }
        ssteps(blk, std::true_type{});
        MO_BARRIER;
      } else {
        const int ptt = wid >> 1, dh = wid & 1;
        bf16x8 vf[2][8], vn[2][8];
#pragma unroll
        for (int a = 0; a < 2; ++a)
#pragma unroll
          for (int ks = 0; ks < 8; ++ks) vf[a][ks] = (bf16x8){0, 0, 0, 0, 0, 0, 0, 0};
        int stepc = 0;
        auto psteps = [&](const int j, auto ownc) {
          constexpr bool own = decltype(ownc)::value;
          const int n = j < 0 ? 0 : (own ? 256 : cnt[j]), ntile = (n + 15) >> 4;
          for (int s0 = 0; s0 < ntile; s0 += 2, ++stepc) {
            const LAS unsigned char* pbuf = Pb + (stepc & 1) * 16384;
            const int tile = s0 + ptt;
            if (tile < ntile && !(mode & 8)) {
              const int rem = n - tile * 16;
              const bool qv = fr < rem;
              const int qidx = own ? tile * 16 + fr : (int)list[j * 256 + tile * 16 + (qv ? fr : 0)];
              u32x4 pw[8];
#pragma unroll
              for (int ks = 0; ks < 8; ++ks) pw[ks] = *(const LAS u32x4*)(pbuf + ptt * 8192 + ks * 1024 + lane * 16);
              LAS f32x4* op0 = (LAS f32x4*)(oacc + mo_oidx(qidx, dh * 8 + fq)); LAS f32x4* op1 = (LAS f32x4*)(oacc + mo_oidx(qidx, dh * 8 + 4 + fq));
              const f32x4 a0 = *op0, a1 = *op1; const float al = lsl[qidx];
              __builtin_amdgcn_sched_barrier(0);
              f32x4 o0 = {0.f, 0.f, 0.f, 0.f}, o1 = {0.f, 0.f, 0.f, 0.f}, ol = {0.f, 0.f, 0.f, 0.f};
              const bf16x8 ones = {0x3F80, 0x3F80, 0x3F80, 0x3F80, 0x3F80, 0x3F80, 0x3F80, 0x3F80};
#pragma unroll
              for (int ks = 0; ks < 8; ++ks) {
                const bf16x8 pb = __builtin_bit_cast(bf16x8, pw[ks]);
                o0 = MFMA16(vf[0][ks], pb, o0); o1 = MFMA16(vf[1][ks], pb, o1);
                if (dh == 0) ol = MFMA16(ones, pb, ol);
              }
              if (qv) {
                *op0 = a0 + o0; *op1 = a1 + o1;
                if (dh == 0 && fq == 0) lsl[qidx] = al + ol[0];
              }
            }
            MO_BARRIER;
          }
        };
        bool first = true;
        for (int j = -1; j < blk; ++j) {
          {
            const bf16_t* vp = Mvt + vrow + ((long)(j + 1) * 64 + dh * 32 + fr) * 256 + fq * 8;
#pragma unroll
            for (int a = 0; a < 2; ++a)
#pragma unroll
              for (int ks = 0; ks < 8; ++ks) vn[a][ks] = *(const bf16x8*)(vp + a * 16 * 256 + ks * 32);
          }
          if (first) { MO_BARRIER; first = false; }
          psteps(j, std::false_type{});
#pragma unroll
          for (int a = 0; a < 2; ++a)
#pragma unroll
            for (int ks = 0; ks < 8; ++ks) vf[a][ks] = vn[a][ks];
        }
        if (first) { MO_BARRIER; first = false; }
        psteps(blk, std::true_type{});
      }
    }
    __syncthreads();
    {
      const int t = tid >> 1, hf = tid & 1;
      const float il = 1.0f / lsl[t];
      bf16_t* dst = (dry ? (bf16_t*)((unsigned char*)p.out + 64 * MiB) : Mq) + qbase + (long)t * 64 + hf * 32;
#pragma unroll
      for (int i = 0; i < 4; ++i) {
        const f32x4 a = *(const LAS f32x4*)(oacc + mo_oidx(t, hf * 8 + 2 * i)), c = *(const LAS f32x4*)(oacc + mo_oidx(t, hf * 8 + 2 * i + 1));
        u32x4 w4; w4.x = pk2(a[0] * il, a[1] * il); w4.y = pk2(a[2] * il, a[3] * il); w4.z = pk2(c[0] * il, c[1] * il); w4.w = pk2(c[2] * il, c[3] * il);
        *(u32x4*)(dst + 8 * i) = w4;
      }
    }
    __syncthreads();
  }
}

constexpr int RO_Q = 0, RO_K = 32768, RO_P = 65536  , RO_PART = 98304, RO_STAT = RO_PART + 8192, RO_TB = 0, RO_TBW = 10240;
DI void ret_out_phase(const Params& p, LAS unsigned char* shm, int mode = 0) {
  const bool dry = mode != 0;
  unsigned char* ws = p.ws;
  int tid_ = threadIdx.x; asm volatile("" : "+v"(tid_)); const int tid = tid_, wid = __builtin_amdgcn_readfirstlane(tid >> 6), lane = tid & 63, fr = lane & 15, fq = lane >> 4;
  const bf16_t* Qr = (const bf16_t*)(ws + OFF_QR); const bf16_t* Kr = (const bf16_t*)(ws + OFF_KR); const bf16_t* Vrt = (const bf16_t*)(ws + OFF_VRT);
  const bf16_t* RT = (const bf16_t*)p.out;
  bf16_t* G = (bf16_t*)(ws + OFF_G);
#define RO_BARRIER do { asm volatile("s_waitcnt lgkmcnt(0)" ::: "memory"); __builtin_amdgcn_s_barrier(); asm volatile("" ::: "memory"); } while (0)
  for (int u = blockIdx.x; u < 1024; u += gridDim.x) {
    const int bh = u >> 6, c = u & 63, h = bh & 3, b = bh >> 2;
    const float gam = exp2f(lg2gamma(h));
    {
      const u32x4* qg = (const u32x4*)(Qr + (long)(bh * 64 + c) * 16384); const u32x4* kg = (const u32x4*)(Kr + (long)(bh * 64 + c) * 16384);
      u32x4 qv[4], kv[4];
#pragma unroll
      for (int i = 0; i < 4; ++i) { qv[i] = qg[tid + i * NTHREADS]; kv[i] = kg[tid + i * NTHREADS]; }
#pragma unroll
      for (int i = 0; i < 4; ++i) { *(LAS u32x4*)(shm + RO_Q + (tid + i * NTHREADS) * 16) = qv[i]; *(LAS u32x4*)(shm + RO_K + (tid + i * NTHREADS) * 16) = kv[i]; }
    }
    bf16x8 rf[2][4], vf[2][4];
    {
      const bf16_t* rp = RT + (long)(bh * 64 + c) * 32768 + (2 * wid) * 2048 + lane * 8;
      const bf16_t* vp = Vrt + (long)(bh * 64 + c) * 32768 + (2 * wid) * 2048 + lane * 8;
#pragma unroll
      for (int e2 = 0; e2 < 2; ++e2)
#pragma unroll
        for (int ks = 0; ks < 4; ++ks) { rf[e2][ks] = *(const bf16x8*)(rp + e2 * 2048 + ks * 512); vf[e2][ks] = *(const bf16x8*)(vp + e2 * 2048 + ks * 512); }
    }
    RO_BARRIER;
    {
      const int ns2 = (16 * wid + 15) / 32 + 1, n = 16 * wid + fr;
      bf16x8 qb[4];
#pragma unroll
      for (int ks = 0; ks < 4; ++ks) qb[ks] = *(const LAS bf16x8*)(shm + RO_Q + (wid * 4 + ks) * 1024 + lane * 16);
      for (int s2 = 0; s2 < ns2; ++s2) {
        f32x4 s[2];
#pragma unroll
        for (int par = 0; par < 2; ++par) {
          s[par] = (f32x4){0.f, 0.f, 0.f, 0.f};
#pragma unroll
          for (int ks = 0; ks < 4; ++ks) { const bf16x8 kf = *(const LAS bf16x8*)(shm + RO_K + ((s2 * 2 + par) * 4 + ks) * 1024 + lane * 16); s[par] = MFMA16(kf, qb[ks], s[par]); }
#pragma unroll
          for (int i = 0; i < 4; ++i) { const int key2 = 32 * s2 + fq * 8 + 4 * par + i; if (key2 > n) s[par][i] = 0.f; }
        }
        u32x4 pw; pw.x = pk2(s[0][0], s[0][1]); pw.y = pk2(s[0][2], s[0][3]); pw.z = pk2(s[1][0], s[1][1]); pw.w = pk2(s[1][2], s[1][3]);
        *(LAS u32x4*)(shm + RO_P + (wid * 4 + s2) * 1024 + lane * 16) = pw;
      }
    }
    RO_BARRIER;
    f32x4 o[2][8];
#pragma unroll
    for (int e2 = 0; e2 < 2; ++e2)
#pragma unroll
      for (int nt = 0; nt < 8; ++nt) o[e2][nt] = (f32x4){0.f, 0.f, 0.f, 0.f};
#pragma unroll
    for (int nt = 0; nt < 8; ++nt) {
#pragma unroll
      for (int ks = 0; ks < 4; ++ks) {
        const bf16x8 qB = *(const LAS bf16x8*)(shm + RO_Q + (nt * 4 + ks) * 1024 + lane * 16);
        o[0][nt] = MFMA16(rf[0][ks], qB, o[0][nt]); o[1][nt] = MFMA16(rf[1][ks], qB, o[1][nt]);
      }
    }
#pragma unroll
    for (int nt = 0; nt < 8; ++nt) {
      o[0][nt] = o[0][nt] * gam; o[1][nt] = o[1][nt] * gam;
#pragma unroll
      for (int s2 = 0; s2 < (16 * nt + 15) / 32 + 1; ++s2) {
        const bf16x8 pB = *(const LAS bf16x8*)(shm + RO_P + (nt * 4 + s2) * 1024 + lane * 16);
        o[0][nt] = MFMA16(vf[0][s2], pB, o[0][nt]); o[1][nt] = MFMA16(vf[1][s2], pB, o[1][nt]);
      }
    }
    {
      LAS f32x2* part = (LAS f32x2*)(shm + RO_PART);
#pragma unroll
      for (int nt = 0; nt < 8; ++nt) {
        float s1 = 0.f, s2q = 0.f;
#pragma unroll
        for (int e2 = 0; e2 < 2; ++e2)
#pragma unroll
          for (int i = 0; i < 4; ++i) { const float v = o[e2][nt][i]; s1 += v; s2q += v * v; }
        s1 += __shfl_xor(s1, 16); s1 += __shfl_xor(s1, 32); s2q += __shfl_xor(s2q, 16); s2q += __shfl_xor(s2q, 32);
        if (fq == 0) part[wid * 128 + nt * 16 + fr] = (f32x2){s1, s2q};
      }
    }
    RO_BARRIER;
    if (tid < 128) {
      const LAS f32x2* part = (const LAS f32x2*)(shm + RO_PART);
      float s1 = 0.f, s2q = 0.f;
#pragma unroll
      for (int w = 0; w < 8; ++w) { const f32x2 v = part[w * 128 + tid]; s1 += v.x; s2q += v.y; }
      const float mu = s1 * (1.0f / 256.0f), var = fmaxf(s2q * (1.0f / 256.0f) - mu * mu, 0.f);
      ((LAS f32x2*)(shm + RO_STAT))[tid] = (f32x2){mu, __builtin_amdgcn_rsqf(var + 1e-5f)};
    }
    RO_BARRIER;
    {
      LAS unsigned char* tb = shm + RO_TB + wid * RO_TBW;
#pragma unroll
      for (int nt = 0; nt < 8; ++nt) {
        const f32x2 st = ((const LAS f32x2*)(shm + RO_STAT))[nt * 16 + fr];
#pragma unroll
        for (int e2 = 0; e2 < 2; ++e2) *(LAS u32x2*)(tb + (nt * 16 + fr) * 80 + (e2 * 16 + 4 * fq) * 2) = pk4((o[e2][nt] - st.x) * st.y);
      }
      asm volatile("s_waitcnt lgkmcnt(0)" ::: "memory");
      bf16_t* gbase = G + ((long)b * SEQ + c * 128) * 1024 + h * 256 + 32 * wid;
      bf16_t* obase = dry ? (bf16_t*)((unsigned char*)p.out + 64 * MiB) + (gbase - G) : gbase;
      u32x4 gv[8];
#pragma unroll
      for (int r = 0; r < 8; ++r) { const int idx = r * 64 + lane; gv[r] = *(const u32x4*)(gbase + (long)(idx >> 2) * 1024 + (idx & 3) * 8); }
#pragma unroll
      for (int r = 0; r < 8; ++r) {
        const int idx = r * 64 + lane, nn = idx >> 2, ch = idx & 3;
        const u32x4 ov = *(const LAS u32x4*)(tb + nn * 80 + ch * 16);
        u32x4 w4;
        { const f32x4 a = unpk4((u32x2){ov.x, ov.y}) * unpk4((u32x2){gv[r].x, gv[r].y}), c2 = unpk4((u32x2){ov.z, ov.w}) * unpk4((u32x2){gv[r].z, gv[r].w});
          w4.x = pk2(a[0], a[1]); w4.y = pk2(a[2], a[3]); w4.z = pk2(c2[0], c2[1]); w4.w = pk2(c2[2], c2[3]); }
        *(u32x4*)(obase + (long)nn * 1024 + ch * 8) = w4;
      }
    }
    __syncthreads();
  }
}

struct SeqMerge {
  const Params& p; bf16_t* tmpb; bf16_t* mixb;
  DI bool get(int i, GUnit& u) const {
    int pm, pn;
    if (!tile_map(i >> 1, 128, 4, pm, pn)) return false;
    unsigned char* ws = p.ws;
    if ((i & 1) == 0) { const int b = pm >> 5, t0 = (pm & 31) * 256;
      u.Ap = (const bf16_t*)(ws + OFF_MQ) + ((long)b * 8 * SEQ + t0) * 64; u.lda = 64; u.ksa = (long)SEQ * 64; u.Bp = (const bf16_t*)(ws + OFF_WMO) + (long)pn * 256 * 512; u.ldb = 512; u.ksb = 64; u.nt = 8; }
    else { u.Ap = (const bf16_t*)(ws + OFF_G) + (long)pm * 256 * 1024; u.lda = 1024; u.ksa = 64; u.Bp = (const bf16_t*)(ws + OFF_WRO) + (long)pn * 256 * 1024; u.ldb = 1024; u.ksb = 64; u.nt = 16; }
    u.pm = pm; u.pn = pn | ((i & 1) << 4); u.permB = 0;
    return true;
  }
  DI void epi(f32x4 (&acc)[2][2][4][2], const GUnit& u) const {
    unsigned char* ws = p.ws;
    int tid_ = threadIdx.x; asm volatile("" : "+v"(tid_)); const int tid = tid_, wid = tid >> 6, lane = tid & 63, wr = wid >> 2, wc = wid & 3, fr = lane & 15, fq = lane >> 4;
    const int pn = u.pn & 15; const bool pass2 = (u.pn >> 4) != 0;
    const bf16_t* gate = (const bf16_t*)(ws + (pass2 ? OFF_GA : OFF_GB)); bf16_t* dst = pass2 ? mixb : tmpb;
#pragma unroll
    for (int ai = 0; ai < 2; ++ai)
#pragma unroll
      for (int m = 0; m < 4; ++m) { asm volatile("" ::: "memory");
        const long row = (long)u.pm * 256 + 128 * ai + 64 * wr + 16 * m + fr;
#pragma unroll
        for (int bj = 0; bj < 2; ++bj) {
          const long off = row * 1024 + pn * 256 + 128 * bj + 32 * wc + 8 * fq;
          const u32x4 g4 = *(const u32x4*)(gate + off);
          f32x4 v0 = unpk4((u32x2){g4.x, g4.y}) * acc[ai][bj][m][0], v1 = unpk4((u32x2){g4.z, g4.w}) * acc[ai][bj][m][1];
          if (pass2) { const u32x4 t4 = *(const u32x4*)(tmpb + off); v0 += unpk4((u32x2){t4.x, t4.y}); v1 += unpk4((u32x2){t4.z, t4.w}); }
          const u32x2 h0 = pk4(v0), h1 = pk4(v1);
          *(u32x4*)(dst + off) = (u32x4){h0.x, h0.y, h1.x, h1.y};
        }
      }
  }
};
DI void phase_merge(const Params& p, LAS unsigned char* shm, bool dry = false) {
  const SeqMerge seq{p, dry ? (bf16_t*)p.out : (bf16_t*)(p.ws + OFF_GB), dry ? (bf16_t*)((unsigned char*)p.out + 64 * MiB) : (bf16_t*)(p.ws + OFF_GA)};
  gemm_stream(seq, shm);
}

struct SeqWo {
  const Params& p; LAS unsigned char* shm;
  DI bool get(int i, GUnit& u) const {
    int pm, pn;
    if (!tile_map(i, 128, 4, pm, pn)) return false;
    u.Ap = (const bf16_t*)(p.ws + OFF_GA) + (long)pm * 256 * 1024; u.Bp = (const bf16_t*)(p.ws + OFF_WO) + (long)pn * 256 * 1024;
    u.lda = 1024; u.ldb = 1024; u.ksa = 64; u.ksb = 64; u.nt = 16; u.pm = pm; u.pn = pn; u.permB = 0;
    return true;
  }
  DI void epi(f32x4 (&acc)[2][2][4][2], const GUnit& u) const {
    unsigned char* ws = p.ws;
    int tid_ = threadIdx.x; asm volatile("" : "+v"(tid_)); const int tid = tid_, wid = tid >> 6, lane = tid & 63, wr = wid >> 2, wc = wid & 3, fr = lane & 15, fq = lane >> 4;
    LAS float* red = (LAS float*)(shm + 131072);
    const int pm = u.pm, pn = u.pn;
#pragma unroll
    for (int ai = 0; ai < 2; ++ai)
#pragma unroll
      for (int m = 0; m < 4; ++m) { asm volatile("" ::: "memory");
        const int rl = 128 * ai + 64 * wr + 16 * m + fr;
        const long row = (long)pm * 256 + rl;
        float ss = 0.f;
#pragma unroll
        for (int bj = 0; bj < 2; ++bj) {
          const long off = row * 1024 + pn * 256 + 128 * bj + 32 * wc + 8 * fq;
          const f32x4 v0 = *(const f32x4*)(p.x + off) + acc[ai][bj][m][0], v1 = *(const f32x4*)(p.x + off + 4) + acc[ai][bj][m][1];
          *(f32x4*)(p.out + off) = v0; *(f32x4*)(p.out + off + 4) = v1;
          const u32x2 h0 = pk4(v0), h1 = pk4(v1);
          *(u32x4*)((bf16_t*)(ws + OFF_X1B) + off) = (u32x4){h0.x, h0.y, h1.x, h1.y};
          ss += ((v0[0] * v0[0] + v0[1] * v0[1]) + (v0[2] * v0[2] + v0[3] * v0[3])) + ((v1[0] * v1[0] + v1[1] * v1[1]) + (v1[2] * v1[2] + v1[3] * v1[3]));
        }
        ss += __shfl_xor(ss, 16); ss += __shfl_xor(ss, 32);
        if (fq == 0) red[wc * 256 + rl] = ss;
      }
    __syncthreads();
    if (tid < 256) ((float*)(ws + OFF_SSQ))[((long)pm * 256 + tid) * 4 + pn] = (red[tid] + red[256 + tid]) + (red[512 + tid] + red[768 + tid]);
    __syncthreads();
  }
};
DI void phase_wo(const Params& p, LAS unsigned char* shm) {
  const SeqWo seq{p, shm};
  gemm_stream(seq, shm);
}

DI void epi_gu(const Params& p, f32x4 (&acc)[2][2][4][2], int pm, int pn, int emode = 0) {
  unsigned char* ws = p.ws;
  int tid_ = threadIdx.x; asm volatile("" : "+v"(tid_)); const int tid = tid_, wid = tid >> 6, lane = tid & 63, wr = wid >> 2, wc = wid & 3, fr = lane & 15, fq = lane >> 4;
  const float* ssq = (const float*)(ws + OFF_SSQ);
  float rsr[2][4];
#pragma unroll
  for (int ai = 0; ai < 2; ++ai)
#pragma unroll
    for (int m = 0; m < 4; ++m) { const long row = (long)pm * 256 + 128 * ai + 64 * wr + 16 * m + fr;
      const f32x4 s4 = *(const f32x4*)(ssq + row * 4);
      rsr[ai][m] = __builtin_amdgcn_rsqf(((s4[0] + s4[1]) + (s4[2] + s4[3])) * (1.0f / DM) + 1e-6f); }
#pragma unroll
  for (int ai = 0; ai < 2; ++ai)
#pragma unroll
    for (int m = 0; m < 4; ++m) { asm volatile("" ::: "memory");
      const long row = (long)pm * 256 + 128 * ai + 64 * wr + 16 * m + fr;
      const float rs = rsr[ai][m];
      {
        u32x2 h[2];
#pragma unroll
        for (int n = 0; n < 2; ++n) {
          const f32x4 g = acc[ai][0][m][n] * rs, uu = acc[ai][1][m][n] * rs; f32x4 o;
#pragma unroll
          for (int j = 0; j < 4; ++j) o[j] = g[j] * sigmoidf_(g[j]) * uu[j];
          h[n] = pk4(o);
        }
        *(u32x4*)((bf16_t*)(ws + OFF_HID) + row * FH + pn * 128 + 32 * wc + 8 * fq) = (u32x4){h[0].x, h[0].y, h[1].x, h[1].y};
      }
    }
}
struct SeqGu {
  const Params& p; int emode;
  DI bool get(int i, GUnit& u) const {
    int pm, pn;
    if (!tile_map(i, 128, 22, pm, pn)) return false;
    u.Ap = (const bf16_t*)(p.ws + OFF_X1B) + (long)pm * 256 * 1024; u.Bp = (const bf16_t*)(p.ws + OFF_WGU) + (long)pn * 256 * 1024;
    u.lda = 1024; u.ldb = 1024; u.ksa = 64; u.ksb = 64; u.nt = 16; u.pm = pm; u.pn = pn; u.permB = 0;
    return true;
  }
  DI void epi(f32x4 (&acc)[2][2][4][2], const GUnit& u) const { if (emode != 2 || p.x == nullptr) epi_gu(p, acc, u.pm, u.pn, emode); }
};
DI void phase_gu(const Params& p, LAS unsigned char* shm, int emode = 0) {
  const SeqGu seq{p, emode};
  gemm_stream(seq, shm);
}

struct SeqDown {
  const Params& p; float* outw;
  DI bool get(int i, GUnit& u) const {
    int pm, pn;
    if (!tile_map(i, 128, 4, pm, pn)) return false;
    u.Ap = (const bf16_t*)(p.ws + OFF_HID) + (long)pm * 256 * FH; u.Bp = (const bf16_t*)(p.ws + OFF_WD) + (long)pn * 256 * FH;
    u.lda = FH; u.ldb = FH; u.ksa = 64; u.ksb = 64; u.nt = FH / 64; u.pm = pm; u.pn = pn; u.permB = 0;
    return true;
  }
  DI void epi(f32x4 (&acc)[2][2][4][2], const GUnit& u) const {
    int tid_ = threadIdx.x; asm volatile("" : "+v"(tid_)); const int tid = tid_, wid = tid >> 6, lane = tid & 63, wr = wid >> 2, wc = wid & 3, fr = lane & 15, fq = lane >> 4;
#pragma unroll
    for (int ai = 0; ai < 2; ++ai)
#pragma unroll
      for (int m = 0; m < 4; ++m) { asm volatile("" ::: "memory");
        const long row = (long)u.pm * 256 + 128 * ai + 64 * wr + 16 * m + fr;
#pragma unroll
        for (int bj = 0; bj < 2; ++bj)
#pragma unroll
          for (int n = 0; n < 2; ++n) {
            const long off = row * 1024 + u.pn * 256 + 128 * bj + 32 * wc + 16 * n + 4 * fq;
            *(f32x4*)(outw + off) = *(const f32x4*)(p.out + off) + acc[ai][bj][m][n];
          }
      }
  }
};
DI void phase_down(const Params& p, LAS unsigned char* shm, bool dry = false) {
  const SeqDown seq{p, dry ? (float*)(p.ws + OFF_MK) : p.out};
  gemm_stream(seq, shm);
}

#define XB_TMO      128
#define XB_XCNT(j)  (256  + 64 * (j))
#define XB_XSUB(j)  (1280 + 64 * (j))
#define XB_XGEN(j)  (2304 + 64 * (j))
#define XB_TOP      3328
#define XB_TOPGEN   3392
#define XCD_BAR_WORDS 3456
#define XB_SPIN_CAP (1u << 18)
DI unsigned xb_ld(unsigned* p) { return __hip_atomic_load(p, __ATOMIC_RELAXED, __HIP_MEMORY_SCOPE_AGENT); }
DI unsigned xb_add(unsigned* p, unsigned v) { return __hip_atomic_fetch_add(p, v, __ATOMIC_RELAXED, __HIP_MEMORY_SCOPE_AGENT); }
DI unsigned xb_xcc_id() { return (unsigned)__builtin_amdgcn_s_getreg((3 << 11) | 20) & 0xFu; }
#define XB_SPIN(cond, bar) do { unsigned _sp = 0; while (cond) { __builtin_amdgcn_s_sleep(1); \
    if ((++_sp & 255u) == 0u) { if (xb_ld(&(bar)[XB_TMO])) break; if (_sp > XB_SPIN_CAP) { atomicAdd(&(bar)[XB_TMO], 1u); break; } } } } while (0)
struct XcdBarrier { unsigned* bar; unsigned x; volatile LAS unsigned* st; };
DI XcdBarrier xcd_barrier_post(unsigned* bar, volatile LAS unsigned* st) {
  XcdBarrier b; b.bar = bar; b.x = xb_xcc_id(); b.st = st;
  if (threadIdx.x == 0) (void)xb_add(&bar[XB_XCNT(b.x)], 1u);
  return b;
}
DI void xcd_barrier_complete(unsigned* bar, unsigned x, unsigned& nloc, unsigned& nx) {
  const unsigned G = gridDim.x * gridDim.y * gridDim.z;
  unsigned sum, cnt, mine, sp = 0u;
  for (;;) {
    sum = 0u; cnt = 0u; mine = 0u;
#pragma unroll
    for (unsigned j = 0; j < 16; ++j) { const unsigned c = xb_ld(&bar[XB_XCNT(j)]); sum += c; cnt += (c > 0u) ? 1u : 0u; mine = (j == x) ? c : mine; }
    if (sum == G) break;
    __builtin_amdgcn_s_sleep(1);
    if ((++sp & 255u) == 0u) { if (xb_ld(&bar[XB_TMO])) break; if (sp > XB_SPIN_CAP) { atomicAdd(&bar[XB_TMO], 1u); break; } }
  }
  nloc = mine > 0u ? mine : 1u; nx = cnt > 0u ? cnt : 1u;
}
DI void xcd_barrier(const XcdBarrier& b) {
  asm volatile("s_waitcnt vmcnt(0)" ::: "memory");
  __syncthreads();
  if (threadIdx.x == 0) {
    unsigned* bar = b.bar;
    __builtin_amdgcn_s_waitcnt(0);
    unsigned nloc = b.st[0], nx = b.st[1];
    if (nloc == 0u) { xcd_barrier_complete(bar, b.x, nloc, nx); b.st[0] = nloc; b.st[1] = nx; }
    const unsigned old = xb_add(&bar[XB_XSUB(b.x)], 1u);
    const unsigned gen = old / nloc;
    if (old + 1u == (gen + 1u) * nloc) {
      __builtin_amdgcn_fence(__ATOMIC_RELEASE, "agent");
      asm volatile("s_waitcnt vmcnt(0)" ::: "memory");
      const unsigned og = xb_add(&bar[XB_TOP], 1u);
      const unsigned tg = og / nx;
      if (og + 1u == (tg + 1u) * nx) xb_add(&bar[XB_TOPGEN], 1u);
      else XB_SPIN(xb_ld(&bar[XB_TOPGEN]) == tg, bar);
      __builtin_amdgcn_fence(__ATOMIC_ACQUIRE, "agent");
      xb_add(&bar[XB_XGEN(b.x)], 1u);
      asm volatile("s_waitcnt vmcnt(0)" ::: "memory");
    } else {
      XB_SPIN(xb_ld(&bar[XB_XGEN(b.x)]) == gen, bar);
      __builtin_amdgcn_fence(__ATOMIC_ACQUIRE, "agent");
      asm volatile("s_waitcnt vmcnt(0)" ::: "memory");
    }
  }
  __syncthreads();
}

__global__ void __launch_bounds__(NTHREADS) fwd_megakernel(Params p) {
  extern __shared__ __attribute__((aligned(16))) unsigned char shm_raw[];
  LAS unsigned char* shm = (LAS unsigned char*)shm_raw;
  cg::grid_group grid = cg::this_grid();
  volatile LAS unsigned* xst = (volatile LAS unsigned*)(shm + LDS_BYTES - 16);
  if (threadIdx.x == 0) { xst[0] = 0u; xst[1] = 0u; }
  unsigned* bar = (unsigned*)(p.ws + OFF_BAR);
  __syncthreads();
  const XcdBarrier xb = xcd_barrier_post(bar, xst);
  phase0(p, shm);
  if (p.x == nullptr) grid.sync();
  xcd_barrier(xb);
  phase1(p, shm);
  xcd_barrier(xb);
  ret_scan(p, shm);
  moba_phase(p, shm);
  xcd_barrier(xb);
  ret_out_phase(p, shm);
  xcd_barrier(xb);
  phase_merge(p, shm);
  xcd_barrier(xb);
  phase_wo(p, shm);
  xcd_barrier(xb);
  phase_gu(p, shm);
  xcd_barrier(xb);
  phase_down(p, shm);
}

extern "C" void kernel_launch(void* const* d_in, const int* in_sizes, int n_in, void* d_out, int out_size, void* d_ws, size_t ws_size, hipStream_t stream) {
  static int grid_blocks = 0;
  if (grid_blocks == 0) {
    if (n_in != 12 || out_size != T_TOK * DM || ws_size < WS_END) { fprintf(stderr, "kernel_launch: unexpected shapes / workspace (n_in %d out %d ws %zu need %zu)\n", n_in, out_size, ws_size, (size_t)WS_END); grid_blocks = -1; return; }
    int dev = 0, cus = 0, per_cu = 0;
    hipGetDevice(&dev);
    hipDeviceGetAttribute(&cus, hipDeviceAttributeMultiprocessorCount, dev);
    if (hipFuncSetAttribute((const void*)fwd_megakernel, hipFuncAttributeMaxDynamicSharedMemorySize, LDS_BYTES) != hipSuccess) { fprintf(stderr, "hipFuncSetAttribute failed\n"); grid_blocks = -1; return; }
    hipOccupancyMaxActiveBlocksPerMultiprocessor(&per_cu, (const void*)fwd_megakernel, NTHREADS, LDS_BYTES);
    if (per_cu < 1) { fprintf(stderr, "occupancy query says %d blocks/CU\n", per_cu); per_cu = 1; }
    if (per_cu > 1) per_cu = 1;
    grid_blocks = cus * per_cu;
  }
  if (grid_blocks < 0) return;
  Params p{};
  p.x = (const float*)d_in[0]; p.norm1_w = (const float*)d_in[1]; p.w_in = (const float*)d_in[2]; p.q_norm_w = (const float*)d_in[3]; p.k_norm_w = (const float*)d_in[4];
  p.w_ret_out = (const float*)d_in[5]; p.w_moba_out = (const float*)d_in[6]; p.w_o = (const float*)d_in[7]; p.norm2_w = (const float*)d_in[8];
  p.w_gate = (const float*)d_in[9]; p.w_up = (const float*)d_in[10]; p.w_down = (const float*)d_in[11];
  p.out = (float*)d_out; p.ws = (unsigned char*)d_ws;
  void* args[] = {&p};
  if (hipMemsetAsync((unsigned char*)d_ws + OFF_BAR, 0, 16384, stream) != hipSuccess) { fprintf(stderr, "hipMemsetAsync of the barrier words failed\n"); return; }
  hipError_t e = hipLaunchCooperativeKernel((const void*)fwd_megakernel, dim3(grid_blocks), dim3(NTHREADS), args, LDS_BYTES, stream);
  if (e != hipSuccess) fprintf(stderr, "cooperative launch failed: %s (grid %d)\n", hipGetErrorString(e), grid_blocks);
}
```

```cpp
#include <hip/hip_runtime.h>
#include <hip/hip_cooperative_groups.h>
#include <cstdio>
#include <cstdint>
#include <type_traits>
namespace cg = cooperative_groups;

#define DI __device__ __forceinline__
#define LAS __attribute__((address_space(3)))
typedef unsigned short bf16_t;
typedef short bf16x8 __attribute__((ext_vector_type(8)));
typedef float f32x4 __attribute__((ext_vector_type(4)));
typedef float f32x2 __attribute__((ext_vector_type(2)));
typedef __bf16 bf16v2 __attribute__((ext_vector_type(2)));
typedef unsigned u32x2 __attribute__((ext_vector_type(2)));
typedef unsigned u32x4 __attribute__((ext_vector_type(4)));

constexpr int T_TOK = 32768, SEQ = 8192, DM = 1024, NCOL = 6656, FH = 2816;
constexpr int NTHREADS = 512;
constexpr int LDS_BYTES = 147456;
constexpr size_t MiB = 1048576;
constexpr size_t OFF_WIN = 0;
constexpr size_t OFF_WRO = OFF_WIN + 13 * MiB;
constexpr size_t OFF_WMO = OFF_WRO + 2 * MiB;
constexpr size_t OFF_WO  = OFF_WMO + 1 * MiB;
constexpr size_t OFF_WGU = OFF_WO + 2 * MiB;
constexpr size_t OFF_WD  = OFF_WGU + 11 * MiB;
constexpr size_t OFF_QR  = OFF_WD + 6 * MiB;
constexpr size_t OFF_KR  = OFF_QR + 32 * MiB;
constexpr size_t OFF_KRT = OFF_KR + 32 * MiB;
constexpr size_t OFF_VRT = OFF_KRT + 32 * MiB;
constexpr size_t OFF_G   = OFF_VRT + 64 * MiB;
constexpr size_t OFF_MQ  = OFF_G + 64 * MiB;
constexpr size_t OFF_MK  = OFF_MQ + 32 * MiB;
constexpr size_t OFF_MVT = OFF_MK + 32 * MiB;
constexpr size_t OFF_GA  = OFF_MVT + 32 * MiB;
constexpr size_t OFF_GB  = OFF_GA + 64 * MiB;
constexpr size_t OFF_MISC = OFF_GB + 64 * MiB;
constexpr size_t OFF_COS = OFF_MISC;
constexpr size_t OFF_SIN = OFF_COS + 2 * MiB;
constexpr size_t OFF_RSTD1 = OFF_SIN + 2 * MiB;
constexpr size_t OFF_SSQ = OFF_RSTD1 + 131072;
constexpr size_t OFF_KBAR = OFF_SSQ + 4 * 131072;
constexpr size_t OFF_SC = OFF_KBAR + 262144;
constexpr size_t OFF_BAR = OFF_SC + 4096;
constexpr size_t OFF_RSTD1Q = OFF_BAR + 16384;
constexpr size_t WS_END = OFF_RSTD1Q + 131072;
constexpr size_t OFF_X1B = OFF_QR;
constexpr size_t OFF_HID = OFF_KRT;

struct Params {
  const float *x, *norm1_w, *w_in, *q_norm_w, *k_norm_w, *w_ret_out, *w_moba_out, *w_o, *norm2_w, *w_gate, *w_up, *w_down;
  float* out;
  unsigned char* ws;
};

DI unsigned pk2(float lo, float hi) { f32x2 v = {lo, hi}; bf16v2 b = __builtin_convertvector(v, bf16v2); return __builtin_bit_cast(unsigned, b); }
DI bf16_t f2bf(float x) { return (bf16_t)(pk2(x, 0.f) & 0xffffu); }
DI u32x2 pk4(f32x4 v) { u32x2 r; r.x = pk2(v[0], v[1]); r.y = pk2(v[2], v[3]); return r; }
DI float bf2f(bf16_t v) { return __uint_as_float(((unsigned)v) << 16); }
DI f32x4 unpk4(u32x2 u) { f32x4 r; r[0] = __uint_as_float(u.x << 16); r[1] = __uint_as_float(u.x & 0xffff0000u); r[2] = __uint_as_float(u.y << 16); r[3] = __uint_as_float(u.y & 0xffff0000u); return r; }
DI float lg2gamma(int h) { return h == 0 ? -0.045803689613124f : (h == 1 ? -0.022720076500083f : (h == 2 ? -0.011315313227834f : -0.005646563141142f)); }
DI float fast_exp2(float x) { return __builtin_amdgcn_exp2f(x); }
DI float sigmoidf_(float v) { return __builtin_amdgcn_rcpf(1.f + fast_exp2(-1.4426950408889634f * v)); }
#define MFMA16(a, b, c) __builtin_amdgcn_mfma_f32_16x16x32_bf16((a), (b), (c), 0, 0, 0)

DI int lds_byte(int r, int c) { const int st = (r >> 4) * 2 + (c >> 5), rr = r & 15, cc = c & 31, ob = rr * 64 + cc * 2; return st * 1024 + (ob ^ (((ob >> 9) & 1) << 5)); }
DI void stage_rc(int b, int& R, int& C) { const int st = b / 1024, sb = b % 1024, swz = sb ^ (((sb >> 9) & 1) << 5); R = (st >> 1) * 16 + swz / 64; C = (st & 1) * 32 + (swz % 64) / 2; }
DI void glds16(const bf16_t* g, LAS unsigned char* l) {
  __builtin_amdgcn_global_load_lds((const __attribute__((address_space(1))) unsigned*)g, (LAS unsigned*)l, 16, 0, 0);
}

DI void gemm_main(const bf16_t* Ap, long lda, long ksa, const bf16_t* Bp, long ldb, long ksb, int nt, LAS unsigned char* shm, f32x4 (&acc)[2][2][4][2], const bool pre = false) {
  int tid_ = threadIdx.x; asm volatile("" : "+v"(tid_)); const int tid = tid_, wid = __builtin_amdgcn_readfirstlane(tid >> 6), lane = tid & 63, wr = wid >> 2, wc = wid & 3, fr = lane & 15, fq = lane >> 4;
  int voffA[2], voffB[2];
#pragma unroll
  for (int i = 0; i < 2; ++i) { int R, C; stage_rc(tid * 16 + i * 8192, R, C); voffA[i] = R * (int)lda + C; voffB[i] = R * (int)ldb + C; }
  const int aoff = lds_byte(wr * 64 + fr, fq * 8), boff = lds_byte(wc * 32 + fr, fq * 8);
  LAS unsigned char* ldsw = shm + wid * 1024;
  const long hA = 128 * lda, hB = 128 * ldb;
#pragma unroll
  for (int ai = 0; ai < 2; ++ai)
#pragma unroll
    for (int bj = 0; bj < 2; ++bj)
#pragma unroll
      for (int m = 0; m < 4; ++m)
#pragma unroll
        for (int n = 0; n < 2; ++n) acc[ai][bj][m][n] = (f32x4){0.f, 0.f, 0.f, 0.f};
  bf16x8 At[4][2], B0[2][2], B1[2][2];
#define G_SA(b, h) (((b) * 2 + (h)) * 16384)
#define G_SB(b, h) ((4 + (b) * 2 + (h)) * 16384)
#define G_STAGE(bufoff, gp, voff) do { const bf16_t* gp_ = (gp); glds16(gp_ + (voff)[0], ldsw + (bufoff)); glds16(gp_ + (voff)[1], ldsw + (bufoff) + 8192); } while (0)
#define G_A0(kt) (Ap + (long)(kt) * ksa)
#define G_A1(kt) (Ap + hA + (long)(kt) * ksa)
#define G_B0(kt) (Bp + (long)(kt) * ksb)
#define G_B1(kt) (Bp + hB + (long)(kt) * ksb)
#define G_LDA(dst, b, h) do { _Pragma("unroll") for (int m = 0; m < 4; ++m) _Pragma("unroll") for (int k = 0; k < 2; ++k) dst[m][k] = *(const LAS bf16x8*)(shm + G_SA(b, h) + aoff + m * 2048 + k * 1024); } while (0)
#define G_LDB(dst, b, h) do { _Pragma("unroll") for (int n = 0; n < 2; ++n) _Pragma("unroll") for (int k = 0; k < 2; ++k) dst[n][k] = *(const LAS bf16x8*)(shm + G_SB(b, h) + boff + n * 2048 + k * 1024); } while (0)
#define G_MMA(ai, bj, A_, B_) do { __builtin_amdgcn_s_setprio(1); _Pragma("unroll") for (int m = 0; m < 4; ++m) _Pragma("unroll") for (int n = 0; n < 2; ++n) _Pragma("unroll") for (int k = 0; k < 2; ++k) \
    acc[ai][bj][m][n] = MFMA16(B_[n][k], A_[m][k], acc[ai][bj][m][n]); __builtin_amdgcn_s_setprio(0); } while (0)
#define G_WAIT_V(n) asm volatile("s_waitcnt vmcnt(" #n ")" ::: "memory")
#define G_WAIT_L(n) asm volatile("s_waitcnt lgkmcnt(" #n ")" ::: "memory")
#define G_BAR __builtin_amdgcn_s_barrier()
#define G_SCHED __builtin_amdgcn_sched_barrier(0)
  G_WAIT_V(0);
  if (!pre) {
    G_STAGE(G_SB(0, 0), G_B0(0), voffB); G_STAGE(G_SA(0, 0), G_A0(0), voffA); G_STAGE(G_SB(0, 1), G_B1(0), voffB); G_STAGE(G_SA(0, 1), G_A1(0), voffA);
    if (wr == 1) G_BAR;
    G_WAIT_V(4); G_BAR;
    G_STAGE(G_SB(1, 0), G_B0(1), voffB); G_STAGE(G_SA(1, 0), G_A0(1), voffA); G_STAGE(G_SB(1, 1), G_B1(1), voffB);
    G_WAIT_V(6); G_BAR;
  } else {
    if (wr == 1) G_BAR;
    G_BAR; G_BAR;
  }
#pragma unroll 1
  for (int t = 0; t < nt - 2; t += 2) {
    G_LDB(B0, 0, 0); G_SCHED; G_LDA(At, 0, 0); G_STAGE(G_SA(1, 1), G_A1(t + 1), voffA);
    G_WAIT_L(8); G_BAR; G_WAIT_L(0); G_MMA(0, 0, At, B0); G_BAR; G_SCHED;
    G_LDB(B1, 0, 1); G_STAGE(G_SB(0, 0), G_B0(t + 2), voffB);
    G_BAR; G_WAIT_L(0); G_MMA(0, 1, At, B1); G_BAR;
    G_LDA(At, 0, 1); G_STAGE(G_SA(0, 0), G_A0(t + 2), voffA);
    G_BAR; G_WAIT_L(0); G_MMA(1, 0, At, B0); G_BAR; G_SCHED;
    G_STAGE(G_SB(0, 1), G_B1(t + 2), voffB);
    G_WAIT_V(6); G_BAR; G_MMA(1, 1, At, B1); G_BAR;
    G_LDB(B0, 1, 0); G_SCHED; G_LDA(At, 1, 0); G_STAGE(G_SA(0, 1), G_A1(t + 2), voffA);
    G_WAIT_L(8); G_BAR; G_WAIT_L(0); G_MMA(0, 0, At, B0); G_BAR; G_SCHED;
    G_LDB(B1, 1, 1); G_STAGE(G_SB(1, 0), G_B0(t + 3), voffB);
    G_BAR; G_WAIT_L(0); G_MMA(0, 1, At, B1); G_BAR;
    G_LDA(At, 1, 1); G_STAGE(G_SA(1, 0), G_A0(t + 3), voffA);
    G_BAR; G_WAIT_L(0); G_MMA(1, 0, At, B0); G_BAR; G_SCHED;
    G_STAGE(G_SB(1, 1), G_B1(t + 3), voffB);
    G_WAIT_V(6); G_BAR; G_MMA(1, 1, At, B1); G_BAR;
  }
  { G_LDB(B0, 0, 0); G_LDA(At, 0, 0); G_STAGE(G_SA(1, 1), G_A1(nt - 1), voffA);
    G_BAR; G_WAIT_L(0); G_MMA(0, 0, At, B0); G_BAR;
    G_LDB(B1, 0, 1); G_BAR; G_WAIT_L(0); G_MMA(0, 1, At, B1); G_BAR;
    G_LDA(At, 0, 1); G_WAIT_V(4); G_BAR; G_WAIT_L(0); G_MMA(1, 0, At, B0); G_MMA(1, 1, At, B1); G_BAR; }
  { G_LDB(B0, 1, 0); G_LDA(At, 1, 0); G_WAIT_V(2); G_BAR; G_WAIT_L(0); G_MMA(0, 0, At, B0); G_BAR;
    G_LDB(B1, 1, 1); G_WAIT_V(0); G_BAR; G_WAIT_L(0); G_MMA(0, 1, At, B1); G_BAR;
    G_LDA(At, 1, 1); G_BAR; G_WAIT_L(0); G_MMA(1, 0, At, B0); G_MMA(1, 1, At, B1); G_BAR; }
  if (wr == 0) G_BAR;
  asm volatile("" ::: "memory");
}

DI void gemm_prefetch(const bf16_t* Ap, long lda, long ksa, const bf16_t* Bp, long ldb, long ksb, LAS unsigned char* shm) {
  int tid_ = threadIdx.x; asm volatile("" : "+v"(tid_)); const int tid = tid_, wid = __builtin_amdgcn_readfirstlane(tid >> 6);
  int voffA[2], voffB[2];
#pragma unroll
  for (int i = 0; i < 2; ++i) { int R, C; stage_rc(tid * 16 + i * 8192, R, C); voffA[i] = R * (int)lda + C; voffB[i] = R * (int)ldb + C; }
  LAS unsigned char* ldsw = shm + wid * 1024;
  const long hA = 128 * lda, hB = 128 * ldb;
  G_STAGE(G_SB(0, 0), G_B0(0), voffB); G_STAGE(G_SA(0, 0), G_A0(0), voffA); G_STAGE(G_SB(0, 1), G_B1(0), voffB); G_STAGE(G_SA(0, 1), G_A1(0), voffA);
  G_STAGE(G_SB(1, 0), G_B0(1), voffB); G_STAGE(G_SA(1, 0), G_A0(1), voffA); G_STAGE(G_SB(1, 1), G_B1(1), voffB);
}

struct GUnit { const bf16_t* Ap; const bf16_t* Bp; int lda, ldb; long ksa, ksb; int nt, pm, pn, permB; };
#define G_STAGE2(bufoff, gp, v0, v1) do { const bf16_t* gp_ = (gp); glds16(gp_ + (v0), ldsw + (bufoff)); glds16(gp_ + (v1), ldsw + (bufoff) + 8192); } while (0)
template <class Seq>
DI void gemm_stream(const Seq& seq, LAS unsigned char* shm, const bool pre = false, const bool has_tail = false, const GUnit tail = GUnit{}) {
  int tid_ = threadIdx.x; asm volatile("" : "+v"(tid_)); const int tid = tid_, wid = __builtin_amdgcn_readfirstlane(tid >> 6), lane = tid & 63, wr = wid >> 2, wc = wid & 3, fr = lane & 15, fq = lane >> 4;
  int R0, C0, R1, C1; stage_rc(tid * 16, R0, C0); stage_rc(tid * 16 + 8192, R1, C1);
  const int aoff = lds_byte(wr * 64 + fr, fq * 8), boff = lds_byte(wc * 32 + fr, fq * 8);
  LAS unsigned char* ldsw = shm + wid * 1024;
  GUnit cur, nxt;
  if (!seq.get(0, cur)) return;
  f32x4 acc[2][2][4][2];
#pragma unroll
  for (int ai = 0; ai < 2; ++ai)
#pragma unroll
    for (int bj = 0; bj < 2; ++bj)
#pragma unroll
      for (int m = 0; m < 4; ++m)
#pragma unroll
        for (int n = 0; n < 2; ++n) acc[ai][bj][m][n] = (f32x4){0.f, 0.f, 0.f, 0.f};
  bf16x8 At[4][2], B0[2][2], B1[2][2];
  const int P0 = (R0 & ~31) + 8 * ((R0 & 15) >> 2) + 4 * ((R0 >> 4) & 1) + (R0 & 3), P1 = (R1 & ~31) + 8 * ((R1 & 15) >> 2) + 4 * ((R1 >> 4) & 1) + (R1 & 3);
  int va0 = R0 * cur.lda + C0, va1 = R1 * cur.lda + C1, vb0 = (cur.permB ? P0 : R0) * cur.ldb + C0, vb1 = (cur.permB ? P1 : R1) * cur.ldb + C1;
  G_WAIT_V(0);
  if (pre) { if (wr == 1) G_BAR; G_BAR; G_BAR; }
  else {
    const bf16_t* Ap = cur.Ap; const bf16_t* Bp = cur.Bp; const long hA = 128L * cur.lda, hB = 128L * cur.ldb;
    G_STAGE2(G_SB(0, 0), Bp, vb0, vb1); G_STAGE2(G_SB(0, 1), Bp + hB, vb0, vb1); G_STAGE2(G_SA(0, 0), Ap, va0, va1); G_STAGE2(G_SA(0, 1), Ap + hA, va0, va1);
    if (wr == 1) G_BAR;
    G_WAIT_V(2); G_BAR;
    G_STAGE2(G_SB(1, 0), Bp + cur.ksb, vb0, vb1); G_STAGE2(G_SA(1, 0), Ap + cur.ksa, va0, va1); G_STAGE2(G_SB(1, 1), Bp + hB + cur.ksb, vb0, vb1);
    G_WAIT_V(6); G_BAR;
  }
  for (int ui = 0;; ++ui) {
    const bool has_next = seq.get(ui + 1, nxt);
    if (!has_next) nxt = has_tail ? tail : cur;
    const int na0 = R0 * nxt.lda + C0, na1 = R1 * nxt.lda + C1, nb0 = (nxt.permB ? P0 : R0) * nxt.ldb + C0, nb1 = (nxt.permB ? P1 : R1) * nxt.ldb + C1;
    const long hA = 128L * cur.lda, hB = 128L * cur.ldb, nhA = 128L * nxt.lda, nhB = 128L * nxt.ldb;
    const int nt = cur.nt;
#pragma unroll 1
    for (int t = 0; t < nt; t += 2) {
      const bool last = t == nt - 2;
      const bf16_t* a1 = cur.Ap + (long)(t + 1) * cur.ksa;
      const bf16_t* a2 = last ? nxt.Ap : cur.Ap + (long)(t + 2) * cur.ksa; const bf16_t* b2 = last ? nxt.Bp : cur.Bp + (long)(t + 2) * cur.ksb;
      const bf16_t* a3 = a2 + (last ? nxt.ksa : cur.ksa); const bf16_t* b3 = b2 + (last ? nxt.ksb : cur.ksb);
      const long h2A = last ? nhA : hA, h2B = last ? nhB : hB;
      const int xa0 = last ? na0 : va0, xa1 = last ? na1 : va1, xb0 = last ? nb0 : vb0, xb1 = last ? nb1 : vb1;
      G_LDB(B0, 0, 0); G_LDB(B1, 0, 1); G_SCHED; G_LDA(At, 0, 0); G_STAGE2(G_SA(1, 1), a1 + hA, va0, va1);
      G_WAIT_V(8); G_WAIT_L(0); G_BAR; G_MMA(0, 0, At, B0); G_MMA(0, 1, At, B1); G_BAR; G_SCHED;
      G_LDA(At, 0, 1); G_STAGE2(G_SB(0, 0), b2, xb0, xb1); G_STAGE2(G_SB(0, 1), b2 + h2B, xb0, xb1); G_STAGE2(G_SA(0, 0), a2, xa0, xa1);
      G_WAIT_V(8); G_WAIT_L(0); G_BAR; G_MMA(1, 0, At, B0); G_MMA(1, 1, At, B1); G_BAR; G_SCHED;
      G_LDB(B0, 1, 0); G_LDB(B1, 1, 1); G_SCHED; G_LDA(At, 1, 0); G_STAGE2(G_SA(0, 1), a2 + h2A, xa0, xa1);
      G_WAIT_V(8); G_WAIT_L(0); G_BAR; G_MMA(0, 0, At, B0); G_MMA(0, 1, At, B1); G_BAR; G_SCHED;
      G_LDA(At, 1, 1); G_STAGE2(G_SB(1, 0), b3, xb0, xb1); G_STAGE2(G_SB(1, 1), b3 + h2B, xb0, xb1); G_STAGE2(G_SA(1, 0), a3, xa0, xa1);
      G_WAIT_V(8); G_WAIT_L(0); G_BAR; G_MMA(1, 0, At, B0); G_MMA(1, 1, At, B1); G_BAR; G_SCHED;
    }
    if (wr == 0) G_BAR;
    asm volatile("" ::: "memory");
    seq.epi(acc, cur);
    if (!has_next) break;
#pragma unroll
    for (int ai = 0; ai < 2; ++ai)
#pragma unroll
      for (int bj = 0; bj < 2; ++bj)
#pragma unroll
        for (int m = 0; m < 4; ++m)
#pragma unroll
          for (int n = 0; n < 2; ++n) acc[ai][bj][m][n] = (f32x4){0.f, 0.f, 0.f, 0.f};
    cur = nxt; va0 = na0; va1 = na1; vb0 = nb0; vb1 = nb1;
    if (wr == 1) G_BAR;
  }
  G_WAIT_V(0);
  __syncthreads();
}

DI bool tile_map(int i, int nM, int nN, int& pm, int& pn) {
  const int G = gridDim.x, c = blockIdx.x;
  if ((G & 7) == 0 && (nM & 63) == 0) {
    const int x = c & 7, loc = c >> 3, per = G >> 3, q = i * per + loc, total = (nM >> 3) * nN;
    if (q >= total) return false;
    const int g = q / (8 * nN), r = q % (8 * nN);
    pm = 8 * (g * 8 + (r & 7)) + x; pn = r >> 3; return true;
  }
  const long L = (long)i * G + c; if (L >= (long)nM * nN) return false;
  pm = (int)(L / nN); pn = (int)(L % nN); return true;
}

template <int MODE>
DI void conv_item(const float* src, const float* src2, const float* rs, bf16_t* dst, int K, int Nsrc, int nblk, LAS float* scr, int item, int lane) {
  const int kb = item / nblk, nb = item % nblk, k0 = 64 * kb, n0 = 32 * nb;
  const int n = n0 + (lane & 31);
  int col = n; float cs = 1.f; const float* s = src;
  if (MODE == 0) {
    if (n < 1024) { const int head = n >> 7, pp = n & 127, half = (pp >> 4) & 1, jj = pp >> 5, i = pp & 15; col = head * 128 + half * 64 + jj * 16 + i; if (n >= 512) cs = 0.08838834764831845f; }
    else if (n >= 3072 && n < 4096) { const int c = (n - 3072) & 255, base = n - c; col = base + 64 * ((c >> 5) & 3) + 32 * (c >> 7) + 8 * ((c & 15) >> 2) + 4 * ((c >> 4) & 1) + (c & 3); }
    else if ((n >= 2048 && n < 3072) || n >= 4608) { const int rho = n & 31; col = (n & ~31) + 8 * ((rho & 15) >> 2) + 4 * (rho >> 4) + (rho & 3); }
  } else if (MODE == 3) {
    const int rho = n & 31; col = (n & ~31) + 8 * ((rho & 15) >> 2) + 4 * (rho >> 4) + (rho & 3);
  } else if (MODE == 1) {
    const int c = n & 255, r7 = c & 127, rho = r7 & 31; col = (n >> 8) * 128 + (r7 & ~31) + 8 * ((rho & 15) >> 2) + 4 * (rho >> 4) + (rho & 3); if (c >> 7) s = src2;
  }
  const float* sp = s + (long)(k0 + (lane >> 5)) * Nsrc + col;
#pragma unroll 8
  for (int i = 0; i < 32; ++i) {
    const int kk = 2 * i + (lane >> 5);
    float w = sp[(long)(2 * i) * Nsrc] * cs;
    if (rs) w *= rs[k0 + kk];
    scr[kk * 33 + (lane & 31)] = w;
  }
  asm volatile("s_waitcnt lgkmcnt(0)" ::: "memory");
  const int c = lane & 7;
#pragma unroll
  for (int j = 0; j < 4; ++j) {
    const int nn = (lane >> 3) + 8 * j; const LAS float* q = scr + (8 * c) * 33 + nn;
    u32x4 o; o.x = pk2(q[0], q[33]); o.y = pk2(q[2 * 33], q[3 * 33]); o.z = pk2(q[4 * 33], q[5 * 33]); o.w = pk2(q[6 * 33], q[7 * 33]);
    *(u32x4*)(dst + (long)(n0 + nn) * K + k0 + 8 * c) = o;
  }
  asm volatile("s_waitcnt lgkmcnt(0)" ::: "memory");
}

DI void phase0(const Params& p, LAS unsigned char* shm, int part = 7) {
  unsigned char* ws = p.ws;
  const long gtid = (long)blockIdx.x * NTHREADS + threadIdx.x, nthr = (long)gridDim.x * NTHREADS;
  const int lane = threadIdx.x & 63, wv = threadIdx.x >> 6, gw = blockIdx.x * 8 + wv, ngw = gridDim.x * 8;
  if (part & 1) {
    bf16_t* xb = (bf16_t*)((unsigned char*)p.out + 64 * MiB);
    float* rstd1 = (float*)(ws + OFF_RSTD1);
    for (int r0 = gw * 4; r0 < T_TOK; r0 += ngw * 4) {
      f32x4 v[4][4];
#pragma unroll
      for (int rr = 0; rr < 4; ++rr) {
        const f32x4* xr = (const f32x4*)(p.x + (long)(r0 + rr) * DM) + lane;
#pragma unroll
        for (int j = 0; j < 4; ++j) v[rr][j] = xr[64 * j];
      }
#pragma unroll
      for (int rr = 0; rr < 4; ++rr) {
        float s = 0.f;
#pragma unroll
        for (int j = 0; j < 4; ++j) s += v[rr][j][0] * v[rr][j][0] + v[rr][j][1] * v[rr][j][1] + v[rr][j][2] * v[rr][j][2] + v[rr][j][3] * v[rr][j][3];
#pragma unroll
        for (int o = 1; o < 64; o <<= 1) s += __shfl_xor(s, o);
        if (lane == 0) { const float rv = 1.0f / sqrtf(s * (1.0f / DM) + 1e-6f); const int r = r0 + rr, rl = r & 255;
          rstd1[r] = rv; ((float*)(ws + OFF_RSTD1Q))[(r & ~255) + (((rl >> 6) & 1) * 16 + (rl & 15)) * 8 + (rl >> 7) * 4 + ((rl >> 4) & 3)] = rv; }
        u32x2* o8 = (u32x2*)(xb + (long)(r0 + rr) * DM) + lane;
#pragma unroll
        for (int j = 0; j < 4; ++j) o8[64 * j] = pk4(v[rr][j]);
      }
    }
  }
  if (part & 2) {
    LAS float* scr = (LAS float*)shm + wv * (64 * 33);
    constexpr int I0 = 16 * 208, I1 = 16 * 32, I2 = 8 * 32, I3 = 16 * 32, I4 = 16 * 176, I5 = 44 * 32;
    for (int it = gw; it < I0 + I1 + I2 + I3 + I4 + I5; it += ngw) {
      int r = it;
      if (r < I0) { conv_item<0>(p.w_in, nullptr, p.norm1_w, (bf16_t*)(ws + OFF_WIN), 1024, NCOL, 208, scr, r, lane); continue; } r -= I0;
      if (r < I1) { conv_item<3>(p.w_ret_out, nullptr, nullptr, (bf16_t*)(ws + OFF_WRO), 1024, 1024, 32, scr, r, lane); continue; } r -= I1;
      if (r < I2) { conv_item<3>(p.w_moba_out, nullptr, nullptr, (bf16_t*)(ws + OFF_WMO), 512, 1024, 32, scr, r, lane); continue; } r -= I2;
      if (r < I3) { conv_item<3>(p.w_o, nullptr, nullptr, (bf16_t*)(ws + OFF_WO), 1024, 1024, 32, scr, r, lane); continue; } r -= I3;
      if (r < I4) { conv_item<1>(p.w_gate, p.w_up, p.norm2_w, (bf16_t*)(ws + OFF_WGU), 1024, FH, 176, scr, r, lane); continue; } r -= I4;
      conv_item<2>(p.w_down, nullptr, nullptr, (bf16_t*)(ws + OFF_WD), FH, 1024, 32, scr, r, lane);
    }
  }
  if (part & 4) {
    float* cosT = (float*)(ws + OFF_COS); float* sinT = (float*)(ws + OFF_SIN);
    for (long idx = gtid; idx < (long)SEQ * 64; idx += nthr) {
      const int pos = (int)(idx >> 6), j = (int)(idx & 63);
      const float inv = exp2f(-(float)j * (13.287712379549449f / 64.0f));
      const float ang = (float)pos * inv;
      const double rev = (double)ang * 0.15915494309189535;
      const float fr = (float)(rev - __builtin_rint(rev));
      cosT[idx] = __builtin_amdgcn_cosf(fr); sinT[idx] = __builtin_amdgcn_sinf(fr);
    }
  }
  if (blockIdx.x == 0 && threadIdx.x < 64) {
    float a = fabsf(p.q_norm_w[threadIdx.x]), b = fabsf(p.k_norm_w[threadIdx.x]);
#pragma unroll
    for (int o = 1; o < 64; o <<= 1) { a = fmaxf(a, __shfl_xor(a, o)); b = fmaxf(b, __shfl_xor(b, o)); }
    if (threadIdx.x == 0) ((float*)(ws + OFF_SC))[0] = 8.0f * a * b * 1.01f;
  }
}

template <int REG>
DI void epi_inproj(const Params& p, f32x4 (&acc)[2][2][4][2], int pm, int pn, LAS unsigned char* shm) {
  unsigned char* ws = p.ws;
  int tid_ = threadIdx.x; asm volatile("" : "+v"(tid_)); const int tid = tid_, wid = tid >> 6, lane = tid & 63, wr = wid >> 2, wc = wid & 3, fr = lane & 15, fq = lane >> 4;
  const int b = pm >> 5, blk = pm & 31, t0 = blk * 256, T0 = pm * 256;
  const float* rstd1 = (const float*)(ws + OFF_RSTD1);
  float rsr[2][4];
  if (REG != 1) {
#pragma unroll
    for (int ai = 0; ai < 2; ++ai)
#pragma unroll
      for (int m = 0; m < 4; ++m) rsr[ai][m] = 0.f;
    const f32x4 q0 = *(const f32x4*)((const float*)(ws + OFF_RSTD1Q) + T0 + (wr * 16 + fr) * 8), q1 = *(const f32x4*)((const float*)(ws + OFF_RSTD1Q) + T0 + (wr * 16 + fr) * 8 + 4);
#pragma unroll
    for (int m = 0; m < 4; ++m) { rsr[0][m] = q0[m]; rsr[1][m] = q1[m]; }
  }
  if (REG == 0) {
    const bool isk = pn >= 2;
    const float* cosT = (const float*)(ws + OFF_COS); const float* sinT = (const float*)(ws + OFF_SIN);
    bf16_t* dstb = (bf16_t*)(ws + (isk ? OFF_KR : OFF_QR));
    bf16_t* krt = (bf16_t*)(ws + OFF_KRT);
#pragma unroll
    for (int ai = 0; ai < 2; ++ai)
#pragma unroll
      for (int m = 0; m < 4; ++m) { asm volatile("" ::: "memory");
        const int r = 128 * ai + 64 * wr + 16 * m + fr, t = t0 + r;
        const float rs = rsr[ai][m];
        const f32x4 cs = *(const f32x4*)(cosT + t * 64 + 16 * wc + 4 * fq), sn = *(const f32x4*)(sinT + t * 64 + 16 * wc + 4 * fq);
#pragma unroll
        for (int bj = 0; bj < 2; ++bj) {
          const int h = 2 * (pn & 1) + bj;
          const float sc = fast_exp2((isk ? -1.f : 1.f) * (float)(t & 127) * lg2gamma(h)) * rs;
          const f32x4 x1 = acc[ai][bj][m][0] * sc, x2 = acc[ai][bj][m][1] * sc;
          const f32x4 y1 = x1 * cs - x2 * sn, y2 = x2 * cs + x1 * sn;
          const int d = 16 * wc + 4 * fq;
          const int tl2 = t & 127, r32 = tl2 & 31;
          const int frag = isk ? (((tl2 >> 5) * 2 + ((r32 >> 2) & 1)) * 4 + (d >> 5)) : ((tl2 >> 4) * 4 + (d >> 5));
          const int frl = isk ? ((r32 >> 3) * 4 + (r32 & 3)) : (tl2 & 15);
          bf16_t* dst = dstb + ((long)((b * 4 + h) * 64 + (t >> 7))) * 16384 + (frag * 64 + ((d >> 3) & 3) * 16 + frl) * 8 + (d & 7);
          const u32x2 o1 = pk4(y1), o2 = pk4(y2);
          *(u32x2*)dst = o1; *(u32x2*)(dst + 2 * 512) = o2;
          if (isk) {
            LAS unsigned char* tb = shm + 135168 + wid * 1024;
            LAS bf16_t* w1 = (LAS bf16_t*)(tb + (4 * fq) * 32 + fr * 2);
            w1[0] = (bf16_t)(o1.x & 0xffff); w1[16] = (bf16_t)(o1.x >> 16); w1[32] = (bf16_t)(o1.y & 0xffff); w1[48] = (bf16_t)(o1.y >> 16);
            LAS bf16_t* w2 = w1 + 16 * 16;
            w2[0] = (bf16_t)(o2.x & 0xffff); w2[16] = (bf16_t)(o2.x >> 16); w2[32] = (bf16_t)(o2.y & 0xffff); w2[48] = (bf16_t)(o2.y >> 16);
            asm volatile("s_waitcnt lgkmcnt(0)" ::: "memory");
            const int dl = lane >> 1, th = lane & 1;
            const u32x4 kv = *(const LAS u32x4*)(tb + dl * 32 + th * 16);
            asm volatile("" ::: "memory");
            const int dd = dl < 16 ? 16 * wc + dl : 48 + 16 * wc + dl;
            const int tb0 = t0 + 128 * ai + 64 * wr + 16 * m + 8 * th, tl = tb0 & 127;
            *(u32x4*)(krt + ((long)((b * 4 + h) * 64 + (tb0 >> 7))) * 16384 + (((dd >> 4) * 4 + (tl >> 5)) * 64 + ((tl >> 3) & 3) * 16 + (dd & 15)) * 8) = kv;
          }
        }
      }
  } else if (REG == 1) {
    const bool isr = pn < 8;
    f32x4 rs4[2][2];
#pragma unroll
    for (int bj = 0; bj < 2; ++bj)
#pragma unroll
      for (int n = 0; n < 2; ++n) rs4[bj][n] = *(const f32x4*)(rstd1 + T0 + 128 * bj + 32 * wc + 8 * fq + 4 * n);
#pragma unroll
    for (int bj = 0; bj < 2; ++bj) {
      const int cB = 128 * bj + 32 * wc + 8 * fq;
#pragma unroll
      for (int ai = 0; ai < 2; ++ai)
#pragma unroll
        for (int m = 0; m < 4; ++m) { asm volatile("" ::: "memory");
          const int rA = 128 * ai + 64 * wr + 16 * m + fr;
          bf16_t* dst;
          if (isr) { const int tl = cB & 127;
            dst = (bf16_t*)(ws + OFF_VRT) + ((long)((b * 4 + (pn - 4)) * 64 + 2 * blk + (cB >> 7))) * 32768 + (((rA >> 4) * 4 + (tl >> 5)) * 64 + ((tl >> 3) & 3) * 16 + (rA & 15)) * 8; }
          else dst = (bf16_t*)(ws + OFF_MVT) + ((long)(((b * 8 + (pn - 16) * 4 + (rA >> 6)) * 32 + blk) * 64 + (rA & 63))) * 256 + cB;
          const u32x2 h0 = pk4(acc[ai][bj][m][0] * rs4[bj][0]), h1 = pk4(acc[ai][bj][m][1] * rs4[bj][1]);
          *(u32x4*)dst = (u32x4){h0.x, h0.y, h1.x, h1.y};
        }
    }
  } else if (REG == 2) {
    bf16_t* dstb; int cb;
    if (pn < 12) { dstb = (bf16_t*)(ws + OFF_G); cb = (pn - 8) * 256; }
    else if (pn < 22) { dstb = (bf16_t*)(ws + OFF_GA); cb = (pn - 18) * 256; }
    else { dstb = (bf16_t*)(ws + OFF_GB); cb = (pn - 22) * 256; }
    const bool silu = pn < 12;
#pragma unroll
    for (int ai = 0; ai < 2; ++ai)
#pragma unroll
      for (int m = 0; m < 4; ++m) { asm volatile("" ::: "memory");
        const int r = 128 * ai + 64 * wr + 16 * m + fr;
        const float rs = rsr[ai][m];
#pragma unroll
        for (int bj = 0; bj < 2; ++bj) {
          u32x2 h[2];
#pragma unroll
          for (int n = 0; n < 2; ++n) {
            f32x4 v = acc[ai][bj][m][n] * rs, o;
#pragma unroll
            for (int j = 0; j < 4; ++j) { const float sg = sigmoidf_(v[j]); o[j] = silu ? v[j] * sg : sg; }
            h[n] = pk4(o);
          }
          *(u32x4*)(dstb + (long)(T0 + r) * 1024 + cb + 128 * bj + 32 * wc + 8 * fq) = (u32x4){h[0].x, h[0].y, h[1].x, h[1].y};
        }
      }
  } else {
    const bool isk = pn >= 14;
    const float* nw = isk ? p.k_norm_w : p.q_norm_w;
    bf16_t* dstb = (bf16_t*)(ws + (isk ? OFF_MK : OFF_MQ));
    const int hh = (pn & 1) * 4 + wc;
    f32x4 w4[2][2], cs4[2][2];
#pragma unroll
    for (int bj = 0; bj < 2; ++bj)
#pragma unroll
      for (int n = 0; n < 2; ++n) { w4[bj][n] = *(const f32x4*)(nw + 32 * bj + 8 * fq + 4 * n); cs4[bj][n] = (f32x4){0.f, 0.f, 0.f, 0.f}; }
#pragma unroll
    for (int ai = 0; ai < 2; ++ai)
#pragma unroll
      for (int m = 0; m < 4; ++m) { asm volatile("" ::: "memory");
        const int r = 128 * ai + 64 * wr + 16 * m + fr, t = t0 + r;
        const float rs = rsr[ai][m];
        f32x4 v[2][2]; float ss = 0.f;
#pragma unroll
        for (int bj = 0; bj < 2; ++bj)
#pragma unroll
          for (int n = 0; n < 2; ++n) { v[bj][n] = acc[ai][bj][m][n] * rs; ss += v[bj][n][0] * v[bj][n][0] + v[bj][n][1] * v[bj][n][1] + v[bj][n][2] * v[bj][n][2] + v[bj][n][3] * v[bj][n][3]; }
        ss += __shfl_xor(ss, 16); ss += __shfl_xor(ss, 32);
        const float rn = __builtin_amdgcn_rsqf(ss * (1.0f / 64.0f) + 1e-6f) * (isk ? 1.0f : 0.125f * 1.4426950408889634f);
        bf16_t* dst = dstb + ((long)((b * 8 + hh) * SEQ + t)) * 64 + 8 * fq;
#pragma unroll
        for (int bj = 0; bj < 2; ++bj) {
          const f32x4 o0 = v[bj][0] * rn * w4[bj][0], o1 = v[bj][1] * rn * w4[bj][1]; cs4[bj][0] += o0; cs4[bj][1] += o1;
          const u32x2 h0 = pk4(o0), h1 = pk4(o1);
          *(u32x4*)(dst + 32 * bj) = (u32x4){h0.x, h0.y, h1.x, h1.y};
        }
      }
    if (isk) {
      LAS float* red = (LAS float*)(shm + 131072);
#pragma unroll
      for (int bj = 0; bj < 2; ++bj)
#pragma unroll
        for (int n = 0; n < 2; ++n)
#pragma unroll
          for (int j = 0; j < 4; ++j) {
            float s = cs4[bj][n][j];
            s += __shfl_xor(s, 1); s += __shfl_xor(s, 2); s += __shfl_xor(s, 4); s += __shfl_xor(s, 8);
            if (fr == 0) red[wr * 256 + wc * 64 + 32 * bj + 8 * fq + 4 * n + j] = s;
          }
      __syncthreads();
      if (tid < 256) {
        float* kbar = (float*)(ws + OFF_KBAR);
        kbar[((long)((b * 8 + (pn & 1) * 4 + (tid >> 6)) * 32 + blk)) * 64 + (tid & 63)] = (red[tid] + red[256 + tid]) * (1.0f / 256.0f);
      }
      __syncthreads();
    }
  }
}

template <int REG>
struct SeqInproj {
  const Params& p; const bf16_t* xb; const bf16_t* W; LAS unsigned char* shm;
  static constexpr int NN = REG == 0 ? 4 : (REG == 1 ? 6 : (REG == 2 ? 12 : 4));
  DI bool get(int i, GUnit& u) const {
    int pm, ix;
    if (!tile_map(i, 128, NN, pm, ix)) return false;
    const int pn = REG == 0 ? ix : (REG == 1 ? (ix < 4 ? 4 + ix : 12 + ix) : (REG == 2 ? (ix < 4 ? 8 + ix : 14 + ix) : 12 + ix));
    const bf16_t* a = xb + (long)pm * 256 * DM; const bf16_t* b = W + (long)pn * 256 * DM;
    u.Ap = REG == 1 ? b : a; u.Bp = REG == 1 ? a : b; u.lda = DM; u.ldb = DM; u.ksa = 64; u.ksb = 64; u.nt = 16; u.pm = pm; u.pn = pn; u.permB = REG == 1;
    return true;
  }
  DI void epi(f32x4 (&acc)[2][2][4][2], const GUnit& u) const { epi_inproj<REG>(p, acc, u.pm, u.pn, shm); }
};
template <int REG>
DI void phase1_region(const Params& p, LAS unsigned char* shm) {
  const SeqInproj<REG> seq{p, (const bf16_t*)((unsigned char*)p.out + 64 * MiB), (const bf16_t*)(p.ws + OFF_WIN), shm};
  gemm_stream(seq, shm);
}
DI void phase1(const Params& p, LAS unsigned char* shm) {
  const bf16_t* xb = (const bf16_t*)((unsigned char*)p.out + 64 * MiB); const bf16_t* W = (const bf16_t*)(p.ws + OFF_WIN);
  bool pre = false;
  { const SeqInproj<2> s{p, xb, W, shm}; const SeqInproj<1> sn{p, xb, W, shm}; GUnit t, t0; const bool h = s.get(0, t0), hn = sn.get(0, t); gemm_stream(s, shm, pre, h && hn, t); pre = h && hn; }
  { const SeqInproj<1> s{p, xb, W, shm}; const SeqInproj<0> sn{p, xb, W, shm}; GUnit t, t0; const bool h = s.get(0, t0), hn = sn.get(0, t); gemm_stream(s, shm, pre, h && hn, t); pre = h && hn; }
  { const SeqInproj<0> s{p, xb, W, shm}; const SeqInproj<3> sn{p, xb, W, shm}; GUnit t, t0; const bool h = s.get(0, t0), hn = sn.get(0, t); gemm_stream(s, shm, pre, h && hn, t); pre = h && hn; }
  { const SeqInproj<3> s{p, xb, W, shm}; gemm_stream(s, shm, pre); }
}

DI void ret_scan(const Params& p, LAS unsigned char* shm) {
  unsigned char* ws = p.ws;
  int tid_ = threadIdx.x; asm volatile("" : "+v"(tid_)); const int tid = tid_, wid = tid >> 6, lane = tid & 63, fr = lane & 15, fq = lane >> 4;
  const bf16_t* Vrt = (const bf16_t*)(ws + OFF_VRT); const bf16_t* Krt = (const bf16_t*)(ws + OFF_KRT);
  bf16_t* RT = (bf16_t*)p.out;
  LAS bf16_t* stg = (LAS bf16_t*)shm;
  for (int u0 = blockIdx.x; u0 < 256; u0 += gridDim.x) {
    int u = u0;
    if (gridDim.x == 256) { const int x = u0 & 7, m = u0 >> 3; u = (2 * x + (m >> 4)) * 16 + (m & 15); }
    const int bh = u >> 4, e0 = (u & 15) * 16, h = bh & 3;
    const float lg = lg2gamma(h), g128 = exp2f(128.f * lg), g127 = exp2f(127.f * lg);
    const bf16_t* vp = Vrt + (long)(bh * 64) * 32768 + (e0 >> 4) * 2048 + lane * 8;
    const bf16_t* kp = Krt + (long)(bh * 64) * 16384 + wid * 2048 + lane * 8;
    f32x4 st = {0.f, 0.f, 0.f, 0.f};
    bf16x8 vb[4][4], kb[4][4];
#pragma unroll
    for (int r = 0; r < 4; ++r)
#pragma unroll
      for (int ks = 0; ks < 4; ++ks) { vb[r][ks] = *(const bf16x8*)(vp + r * 32768 + ks * 512); kb[r][ks] = *(const bf16x8*)(kp + r * 16384 + ks * 512); }
#pragma unroll 1
    for (int c0 = 0; c0 < 64; c0 += 8) {
#pragma unroll
      for (int s = 0; s < 8; ++s) {
        const int r = s & 3, c = c0 + s;
        LAS bf16_t* sp = stg + (s * 16 + 4 * fq) * 136 + 16 * wid + fr;
        sp[0] = f2bf(st[0]); sp[136] = f2bf(st[1]); sp[272] = f2bf(st[2]); sp[408] = f2bf(st[3]);
        f32x4 uacc = {0.f, 0.f, 0.f, 0.f};
#pragma unroll
        for (int ks = 0; ks < 4; ++ks) uacc = MFMA16(vb[r][ks], kb[r][ks], uacc);
        st = st * g128 + uacc * g127;
        const int cn = c + 4 < 64 ? c + 4 : 63;
#pragma unroll
        for (int ks = 0; ks < 4; ++ks) { vb[r][ks] = *(const bf16x8*)(vp + cn * 32768 + ks * 512); kb[r][ks] = *(const bf16x8*)(kp + cn * 16384 + ks * 512); }
      }
      __syncthreads();
#pragma unroll
      for (int i = 0; i < 4; ++i) {
        const int pc = tid + i * NTHREADS, s = pc >> 8, ch = (pc >> 4) & 15, el = pc & 15;
        const u32x4 v = *(const LAS u32x4*)(stg + (s * 16 + el) * 136 + ch * 8);
        *(u32x4*)(RT + (long)(bh * 64 + c0 + s) * 32768 + ((((e0 >> 4) * 4 + (ch >> 2)) * 64 + (ch & 3) * 16 + el) * 8)) = v;
      }
      __syncthreads();
    }
  }
}

constexpr int MO_QS = 144;
constexpr int MO_OACC = 0, MO_L = 256 * 64 * 4, MO_CNT = MO_L + 1024, MO_LIST = MO_CNT + 128, MO_Q = MO_LIST + 32 * 256, MO_P = MO_Q + 256 * MO_QS, MO_KBAR = MO_P, MO_END = MO_P + 32768;
static_assert(MO_END <= LDS_BYTES, "moba lds");
DI int mo_oidx(int q, int d4) { return q * 64 + ((d4 ^ (q & 15)) << 2); }

DI void moba_loadkv(const bf16_t* Mk, const bf16_t* Mvt, long krow0, long vrow, int j, int w, int fr, int fq, bf16x8 (&kf)[2][2], bf16x8 (&vf)[8]) {
  const int prow = (fr >> 2) * 8 + (fr & 3);
  const bf16_t* kp = Mk + (krow0 + j * 256 + 32 * w + prow) * 64 + fq * 8;
  kf[0][0] = *(const bf16x8*)kp; kf[0][1] = *(const bf16x8*)(kp + 32); kf[1][0] = *(const bf16x8*)(kp + 256); kf[1][1] = *(const bf16x8*)(kp + 288);
  const bf16_t* vp = Mvt + vrow + ((long)j * 64 + (w & 3) * 16 + fr) * 256 + fq * 8;
#pragma unroll
  for (int ks = 0; ks < 8; ++ks) vf[ks] = *(const bf16x8*)(vp + ks * 32);
}

DI void moba_phase(const Params& p, LAS unsigned char* shm, int mode = 0) {
  const bool dry = mode != 0;
  unsigned char* ws = p.ws;
  int tid_ = threadIdx.x; asm volatile("" : "+v"(tid_)); const int tid = tid_, wid = __builtin_amdgcn_readfirstlane(tid >> 6), lane = tid & 63, fr = lane & 15, fq = lane >> 4;
  const bf16_t* Mk = (const bf16_t*)(ws + OFF_MK); const bf16_t* Mvt = (const bf16_t*)(ws + OFF_MVT);
  bf16_t* Mq = (bf16_t*)(ws + OFF_MQ);
  const float* kbarg = (const float*)(ws + OFF_KBAR);
  const float mb = ((const float*)(ws + OFF_SC))[0];
  const float c2 = mb * 1.4426950408889634f;
  LAS float* oacc = (LAS float*)(shm + MO_OACC); LAS float* lsl = (LAS float*)(shm + MO_L); LAS float* kb = (LAS float*)(shm + MO_KBAR);
  LAS int* cnt = (LAS int*)(shm + MO_CNT); LAS unsigned char* list = shm + MO_LIST; LAS unsigned char* Qs = shm + MO_Q; LAS unsigned char* Pb = shm + MO_P;
  const int dtw = wid & 3, ttw = wid >> 2;
  for (int u = blockIdx.x, it = 0; u < 1024; u += gridDim.x, ++it) {
    int blk = 31 - (u >> 5), bh = u & 31;
    if (gridDim.x == 256) {
      const int x = blockIdx.x & 7, m = blockIdx.x >> 3, m2 = (m + 16) & 31;
      bh = x + 8 * it; blk = it == 0 ? 31 - m : (it == 1 ? m : (it == 2 ? m2 : 31 - m2));
    }
    const long qbase = ((long)bh * SEQ + blk * 256) * 64;
    for (int i = tid; i < 256 * 64; i += NTHREADS) oacc[i] = 0.f;
    if (tid < 256) lsl[tid] = 0.f;
    if (tid < 32) cnt[tid] = 0;
    for (int i = tid; i < blk * 64; i += NTHREADS) kb[i] = kbarg[((long)bh * 32) * 64 + i];
    const int qt = tid >> 1, qh = tid & 1;
    u32x4 qw[4];
    {
      const u32x4* qp = (const u32x4*)(Mq + qbase + (long)qt * 64 + qh * 32);
#pragma unroll
      for (int i = 0; i < 4; ++i) { qw[i] = qp[i]; *(LAS u32x4*)(Qs + qt * MO_QS + qh * 64 + i * 16) = qw[i]; }
    }
    __syncthreads();
    if (blk > 0) {
      float q[32];
#pragma unroll
      for (int i = 0; i < 4; ++i) { const u32x4 w4 = qw[i]; q[8 * i] = __uint_as_float(w4.x << 16); q[8 * i + 1] = __uint_as_float(w4.x & 0xffff0000u); q[8 * i + 2] = __uint_as_float(w4.y << 16); q[8 * i + 3] = __uint_as_float(w4.y & 0xffff0000u);
        q[8 * i + 4] = __uint_as_float(w4.z << 16); q[8 * i + 5] = __uint_as_float(w4.z & 0xffff0000u); q[8 * i + 6] = __uint_as_float(w4.w << 16); q[8 * i + 7] = __uint_as_float(w4.w & 0xffff0000u); }
      float v0 = -3e38f, v1 = -3e38f, v2 = -3e38f; int i0 = -1, i1 = -1, i2 = -1;
      for (int j = 0; j < blk; ++j) {
        float g0 = 0.f, g1 = 0.f;
#pragma unroll
        for (int d = 0; d < 32; d += 8) { const f32x4 k4 = *(const LAS f32x4*)(kb + j * 64 + qh * 32 + d), k5 = *(const LAS f32x4*)(kb + j * 64 + qh * 32 + d + 4);
          g0 += q[d] * k4[0] + q[d + 1] * k4[1] + q[d + 2] * k4[2] + q[d + 3] * k4[3]; g1 += q[d + 4] * k5[0] + q[d + 5] * k5[1] + q[d + 6] * k5[2] + q[d + 7] * k5[3]; }
        float g = g0 + g1;
        g += __shfl_xor(g, 1);
        if (g > v0) { v2 = v1; i2 = i1; v1 = v0; i1 = i0; v0 = g; i0 = j; }
        else if (g > v1) { v2 = v1; i2 = i1; v1 = g; i1 = j; }
        else if (g > v2) { v2 = g; i2 = j; }
      }
      if (qh == 0) {
        if (i0 >= 0) { const int pz = atomicAdd((int*)(cnt + i0), 1); list[i0 * 256 + pz] = (unsigned char)qt; }
        if (i1 >= 0) { const int pz = atomicAdd((int*)(cnt + i1), 1); list[i1 * 256 + pz] = (unsigned char)qt; }
        if (i2 >= 0) { const int pz = atomicAdd((int*)(cnt + i2), 1); list[i2 * 256 + pz] = (unsigned char)qt; }
      }
    }
    __syncthreads();
    const long krow0 = (long)bh * SEQ, vrow = (long)bh * 64 * SEQ;
#define MO_BARRIER do { asm volatile("s_waitcnt lgkmcnt(0)" ::: "memory"); __builtin_amdgcn_s_barrier(); asm volatile("" ::: "memory"); } while (0)
    if (mode != 2) {
      if (wid >= 4) {
        const int sw = wid & 3, prow = (fr >> 2) * 8 + (fr & 3);
        bf16x8 kf[4][2], kn[4][2];
#pragma unroll
        for (int a = 0; a < 4; ++a) { kf[a][0] = (bf16x8){0, 0, 0, 0, 0, 0, 0, 0}; kf[a][1] = kf[a][0]; }
        int stepc = 0;
        auto ssteps = [&](const int j, auto ownc) {
          constexpr bool own = decltype(ownc)::value;
          const int n = j < 0 ? 0 : (own ? 256 : cnt[j]), ntile = (n + 15) >> 4;
          for (int s0 = 0; s0 < ntile; s0 += 2, ++stepc) {
            LAS unsigned char* pbuf = Pb + (stepc & 1) * 16384;
            if (!(mode & 4))
#pragma unroll
            for (int tt = 0; tt < 2; ++tt) {
              const int tile = s0 + tt;
              if (tile < ntile) {
                const int rem = n - tile * 16;
                const int qidx = own ? tile * 16 + fr : (int)list[j * 256 + tile * 16 + (fr < rem ? fr : 0)];
                const bf16x8 q0 = *(const LAS bf16x8*)(Qs + qidx * MO_QS + fq * 16), q1 = *(const LAS bf16x8*)(Qs + qidx * MO_QS + 64 + fq * 16);
#pragma unroll
                for (int g = 0; g < 2; ++g) {
                  f32x4 sv[2];
#pragma unroll
                  for (int par = 0; par < 2; ++par) { sv[par] = MFMA16(kf[g * 2 + par][0], q0, ((f32x4){0.f, 0.f, 0.f, 0.f})); sv[par] = MFMA16(kf[g * 2 + par][1], q1, sv[par]); }
                  float pv[2][4];
#pragma unroll
                  for (int par = 0; par < 2; ++par)
#pragma unroll
                    for (int i = 0; i < 4; ++i) {
                      float pe = fast_exp2(sv[par][i] - c2);
                      if (own) { const int key = 64 * sw + 32 * g + fq * 8 + 4 * par + i; if (key > qidx) pe = 0.f; }
                      pv[par][i] = pe;
                    }
                  u32x4 pw; pw.x = pk2(pv[0][0], pv[0][1]); pw.y = pk2(pv[0][2], pv[0][3]); pw.z = pk2(pv[1][0], pv[1][1]); pw.w = pk2(pv[1][2], pv[1][3]);
                  *(LAS u32x4*)(pbuf + tt * 8192 + (2 * sw + g) * 1024 + lane * 16) = pw;
                }
              }
            }
            MO_BARRIER;
          }
        };
        for (int j = -1; j < blk; ++j) {
          {
            const bf16_t* kp = Mk + (krow0 + (j + 1) * 256 + 64 * sw + prow) * 64 + fq * 8;
#pragma unroll
            for (int g = 0; g < 2; ++g)
#pragma unroll
              for (int par = 0; par < 2; ++par) { kn[g * 2 + par][0] = *(const bf16x8*)(kp + (32 * g + 4 * par) * 64); kn[g * 2 + par][1] = *(const bf16x8*)(kp + (32 * g + 4 * par) * 64 + 32); }
          }
          ssteps(j, std::false_type{});
#pragma unroll
          for (int a = 0; a < 4; ++a) { kf[a][0] = kn[a][0]; kf[a][1] = kn[a][1]; }
        }
        ssteps(blk, std::true_type{});
        MO_BARRIER;
      } else {
        const int ptt = wid >> 1, dh = wid & 1;
        bf16x8 vf[2][8], vn[2][8];
#pragma unroll
        for (int a = 0; a < 2; ++a)
#pragma unroll
          for (int ks = 0; ks < 8; ++ks) vf[a][ks] = (bf16x8){0, 0, 0, 0, 0, 0, 0, 0};
        int stepc = 0;
        auto psteps = [&](const int j, auto ownc) {
          constexpr bool own = decltype(ownc)::value;
          const int n = j < 0 ? 0 : (own ? 256 : cnt[j]), ntile = (n + 15) >> 4;
          for (int s0 = 0; s0 < ntile; s0 += 2, ++stepc) {
            const LAS unsigned char* pbuf = Pb + (stepc & 1) * 16384;
            const int tile = s0 + ptt;
            if (tile < ntile && !(mode & 8)) {
              const int rem = n - tile * 16;
              const bool qv = fr < rem;
              const int qidx = own ? tile * 16 + fr : (int)list[j * 256 + tile * 16 + (qv ? fr : 0)];
              u32x4 pw[8];
#pragma unroll
              for (int ks = 0; ks < 8; ++ks) pw[ks] = *(const LAS u32x4*)(pbuf + ptt * 8192 + ks * 1024 + lane * 16);
              LAS f32x4* op0 = (LAS f32x4*)(oacc + mo_oidx(qidx, dh * 8 + fq)); LAS f32x4* op1 = (LAS f32x4*)(oacc + mo_oidx(qidx, dh * 8 + 4 + fq));
              const f32x4 a0 = *op0, a1 = *op1; const float al = lsl[qidx];
              __builtin_amdgcn_sched_barrier(0);
              f32x4 o0 = {0.f, 0.f, 0.f, 0.f}, o1 = {0.f, 0.f, 0.f, 0.f}, ol = {0.f, 0.f, 0.f, 0.f};
              const bf16x8 ones = {0x3F80, 0x3F80, 0x3F80, 0x3F80, 0x3F80, 0x3F80, 0x3F80, 0x3F80};
#pragma unroll
              for (int ks = 0; ks < 8; ++ks) {
                const bf16x8 pb = __builtin_bit_cast(bf16x8, pw[ks]);
                o0 = MFMA16(vf[0][ks], pb, o0); o1 = MFMA16(vf[1][ks], pb, o1);
                if (dh == 0) ol = MFMA16(ones, pb, ol);
              }
              if (qv) {
                *op0 = a0 + o0; *op1 = a1 + o1;
                if (dh == 0 && fq == 0) lsl[qidx] = al + ol[0];
              }
            }
            MO_BARRIER;
          }
        };
        bool first = true;
        for (int j = -1; j < blk; ++j) {
          {
            const bf16_t* vp = Mvt + vrow + ((long)(j + 1) * 64 + dh * 32 + fr) * 256 + fq * 8;
#pragma unroll
            for (int a = 0; a < 2; ++a)
#pragma unroll
              for (int ks = 0; ks < 8; ++ks) vn[a][ks] = *(const bf16x8*)(vp + a * 16 * 256 + ks * 32);
          }
          if (first) { MO_BARRIER; first = false; }
          psteps(j, std::false_type{});
#pragma unroll
          for (int a = 0; a < 2; ++a)
#pragma unroll
            for (int ks = 0; ks < 8; ++ks) vf[a][ks] = vn[a][ks];
        }
        if (first) { MO_BARRIER; first = false; }
        psteps(blk, std::true_type{});
      }
    }
    __syncthreads();
    {
      const int t = tid >> 1, hf = tid & 1;
      const float il = 1.0f / lsl[t];
      bf16_t* dst = (dry ? (bf16_t*)((unsigned char*)p.out + 64 * MiB) : Mq) + qbase + (long)t * 64 + hf * 32;
#pragma unroll
      for (int i = 0; i < 4; ++i) {
        const f32x4 a = *(const LAS f32x4*)(oacc + mo_oidx(t, hf * 8 + 2 * i)), c = *(const LAS f32x4*)(oacc + mo_oidx(t, hf * 8 + 2 * i + 1));
        u32x4 w4; w4.x = pk2(a[0] * il, a[1] * il); w4.y = pk2(a[2] * il, a[3] * il); w4.z = pk2(c[0] * il, c[1] * il); w4.w = pk2(c[2] * il, c[3] * il);
        *(u32x4*)(dst + 8 * i) = w4;
      }
    }
    __syncthreads();
  }
}

constexpr int RO_Q = 0, RO_K = 32768, RO_P = 65536  , RO_PART = 98304, RO_STAT = RO_PART + 8192, RO_TB = 0, RO_TBW = 10240;
DI void ret_out_phase(const Params& p, LAS unsigned char* shm, int mode = 0) {
  const bool dry = mode != 0;
  unsigned char* ws = p.ws;
  int tid_ = threadIdx.x; asm volatile("" : "+v"(tid_)); const int tid = tid_, wid = __builtin_amdgcn_readfirstlane(tid >> 6), lane = tid & 63, fr = lane & 15, fq = lane >> 4;
  const bf16_t* Qr = (const bf16_t*)(ws + OFF_QR); const bf16_t* Kr = (const bf16_t*)(ws + OFF_KR); const bf16_t* Vrt = (const bf16_t*)(ws + OFF_VRT);
  const bf16_t* RT = (const bf16_t*)p.out;
  bf16_t* G = (bf16_t*)(ws + OFF_G);
#define RO_BARRIER do { asm volatile("s_waitcnt lgkmcnt(0)" ::: "memory"); __builtin_amdgcn_s_barrier(); asm volatile("" ::: "memory"); } while (0)
  for (int u = blockIdx.x; u < 1024; u += gridDim.x) {
    const int bh = u >> 6, c = u & 63, h = bh & 3, b = bh >> 2;
    const float gam = exp2f(lg2gamma(h));
    {
      const u32x4* qg = (const u32x4*)(Qr + (long)(bh * 64 + c) * 16384); const u32x4* kg = (const u32x4*)(Kr + (long)(bh * 64 + c) * 16384);
      u32x4 qv[4], kv[4];
#pragma unroll
      for (int i = 0; i < 4; ++i) { qv[i] = qg[tid + i * NTHREADS]; kv[i] = kg[tid + i * NTHREADS]; }
#pragma unroll
      for (int i = 0; i < 4; ++i) { *(LAS u32x4*)(shm + RO_Q + (tid + i * NTHREADS) * 16) = qv[i]; *(LAS u32x4*)(shm + RO_K + (tid + i * NTHREADS) * 16) = kv[i]; }
    }
    bf16x8 rf[2][4], vf[2][4];
    {
      const bf16_t* rp = RT + (long)(bh * 64 + c) * 32768 + (2 * wid) * 2048 + lane * 8;
      const bf16_t* vp = Vrt + (long)(bh * 64 + c) * 32768 + (2 * wid) * 2048 + lane * 8;
#pragma unroll
      for (int e2 = 0; e2 < 2; ++e2)
#pragma unroll
        for (int ks = 0; ks < 4; ++ks) { rf[e2][ks] = *(const bf16x8*)(rp + e2 * 2048 + ks * 512); vf[e2][ks] = *(const bf16x8*)(vp + e2 * 2048 + ks * 512); }
    }
    RO_BARRIER;
    {
      const int ns2 = (16 * wid + 15) / 32 + 1, n = 16 * wid + fr;
      bf16x8 qb[4];
#pragma unroll
      for (int ks = 0; ks < 4; ++ks) qb[ks] = *(const LAS bf16x8*)(shm + RO_Q + (wid * 4 + ks) * 1024 + lane * 16);
      for (int s2 = 0; s2 < ns2; ++s2) {
        f32x4 s[2];
#pragma unroll
        for (int par = 0; par < 2; ++par) {
          s[par] = (f32x4){0.f, 0.f, 0.f, 0.f};
#pragma unroll
          for (int ks = 0; ks < 4; ++ks) { const bf16x8 kf = *(const LAS bf16x8*)(shm + RO_K + ((s2 * 2 + par) * 4 + ks) * 1024 + lane * 16); s[par] = MFMA16(kf, qb[ks], s[par]); }
#pragma unroll
          for (int i = 0; i < 4; ++i) { const int key2 = 32 * s2 + fq * 8 + 4 * par + i; if (key2 > n) s[par][i] = 0.f; }
        }
        u32x4 pw; pw.x = pk2(s[0][0], s[0][1]); pw.y = pk2(s[0][2], s[0][3]); pw.z = pk2(s[1][0], s[1][1]); pw.w = pk2(s[1][2], s[1][3]);
        *(LAS u32x4*)(shm + RO_P + (wid * 4 + s2) * 1024 + lane * 16) = pw;
      }
    }
    RO_BARRIER;
    f32x4 o[2][8];
#pragma unroll
    for (int e2 = 0; e2 < 2; ++e2)
#pragma unroll
      for (int nt = 0; nt < 8; ++nt) o[e2][nt] = (f32x4){0.f, 0.f, 0.f, 0.f};
#pragma unroll
    for (int nt = 0; nt < 8; ++nt) {
#pragma unroll
      for (int ks = 0; ks < 4; ++ks) {
        const bf16x8 qB = *(const LAS bf16x8*)(shm + RO_Q + (nt * 4 + ks) * 1024 + lane * 16);
        o[0][nt] = MFMA16(rf[0][ks], qB, o[0][nt]); o[1][nt] = MFMA16(rf[1][ks], qB, o[1][nt]);
      }
    }
#pragma unroll
    for (int nt = 0; nt < 8; ++nt) {
      o[0][nt] = o[0][nt] * gam; o[1][nt] = o[1][nt] * gam;
#pragma unroll
      for (int s2 = 0; s2 < (16 * nt + 15) / 32 + 1; ++s2) {
        const bf16x8 pB = *(const LAS bf16x8*)(shm + RO_P + (nt * 4 + s2) * 1024 + lane * 16);
        o[0][nt] = MFMA16(vf[0][s2], pB, o[0][nt]); o[1][nt] = MFMA16(vf[1][s2], pB, o[1][nt]);
      }
    }
    {
      LAS f32x2* part = (LAS f32x2*)(shm + RO_PART);
#pragma unroll
      for (int nt = 0; nt < 8; ++nt) {
        float s1 = 0.f, s2q = 0.f;
#pragma unroll
        for (int e2 = 0; e2 < 2; ++e2)
#pragma unroll
          for (int i = 0; i < 4; ++i) { const float v = o[e2][nt][i]; s1 += v; s2q += v * v; }
        s1 += __shfl_xor(s1, 16); s1 += __shfl_xor(s1, 32); s2q += __shfl_xor(s2q, 16); s2q += __shfl_xor(s2q, 32);
        if (fq == 0) part[wid * 128 + nt * 16 + fr] = (f32x2){s1, s2q};
      }
    }
    RO_BARRIER;
    if (tid < 128) {
      const LAS f32x2* part = (const LAS f32x2*)(shm + RO_PART);
      float s1 = 0.f, s2q = 0.f;
#pragma unroll
      for (int w = 0; w < 8; ++w) { const f32x2 v = part[w * 128 + tid]; s1 += v.x; s2q += v.y; }
      const float mu = s1 * (1.0f / 256.0f), var = fmaxf(s2q * (1.0f / 256.0f) - mu * mu, 0.f);
      ((LAS f32x2*)(shm + RO_STAT))[tid] = (f32x2){mu, __builtin_amdgcn_rsqf(var + 1e-5f)};
    }
    RO_BARRIER;
    {
      LAS unsigned char* tb = shm + RO_TB + wid * RO_TBW;
#pragma unroll
      for (int nt = 0; nt < 8; ++nt) {
        const f32x2 st = ((const LAS f32x2*)(shm + RO_STAT))[nt * 16 + fr];
#pragma unroll
        for (int e2 = 0; e2 < 2; ++e2) *(LAS u32x2*)(tb + (nt * 16 + fr) * 80 + (e2 * 16 + 4 * fq) * 2) = pk4((o[e2][nt] - st.x) * st.y);
      }
      asm volatile("s_waitcnt lgkmcnt(0)" ::: "memory");
      bf16_t* gbase = G + ((long)b * SEQ + c * 128) * 1024 + h * 256 + 32 * wid;
      bf16_t* obase = dry ? (bf16_t*)((unsigned char*)p.out + 64 * MiB) + (gbase - G) : gbase;
      u32x4 gv[8];
#pragma unroll
      for (int r = 0; r < 8; ++r) { const int idx = r * 64 + lane; gv[r] = *(const u32x4*)(gbase + (long)(idx >> 2) * 1024 + (idx & 3) * 8); }
#pragma unroll
      for (int r = 0; r < 8; ++r) {
        const int idx = r * 64 + lane, nn = idx >> 2, ch = idx & 3;
        const u32x4 ov = *(const LAS u32x4*)(tb + nn * 80 + ch * 16);
        u32x4 w4;
        { const f32x4 a = unpk4((u32x2){ov.x, ov.y}) * unpk4((u32x2){gv[r].x, gv[r].y}), c2 = unpk4((u32x2){ov.z, ov.w}) * unpk4((u32x2){gv[r].z, gv[r].w});
          w4.x = pk2(a[0], a[1]); w4.y = pk2(a[2], a[3]); w4.z = pk2(c2[0], c2[1]); w4.w = pk2(c2[2], c2[3]); }
        *(u32x4*)(obase + (long)nn * 1024 + ch * 8) = w4;
      }
    }
    __syncthreads();
  }
}

struct SeqMerge {
  const Params& p; bf16_t* tmpb; bf16_t* mixb;
  DI bool get(int i, GUnit& u) const {
    int pm, pn;
    if (!tile_map(i >> 1, 128, 4, pm, pn)) return false;
    unsigned char* ws = p.ws;
    if ((i & 1) == 0) { const int b = pm >> 5, t0 = (pm & 31) * 256;
      u.Ap = (const bf16_t*)(ws + OFF_MQ) + ((long)b * 8 * SEQ + t0) * 64; u.lda = 64; u.ksa = (long)SEQ * 64; u.Bp = (const bf16_t*)(ws + OFF_WMO) + (long)pn * 256 * 512; u.ldb = 512; u.ksb = 64; u.nt = 8; }
    else { u.Ap = (const bf16_t*)(ws + OFF_G) + (long)pm * 256 * 1024; u.lda = 1024; u.ksa = 64; u.Bp = (const bf16_t*)(ws + OFF_WRO) + (long)pn * 256 * 1024; u.ldb = 1024; u.ksb = 64; u.nt = 16; }
    u.pm = pm; u.pn = pn | ((i & 1) << 4); u.permB = 0;
    return true;
  }
  DI void epi(f32x4 (&acc)[2][2][4][2], const GUnit& u) const {
    unsigned char* ws = p.ws;
    int tid_ = threadIdx.x; asm volatile("" : "+v"(tid_)); const int tid = tid_, wid = tid >> 6, lane = tid & 63, wr = wid >> 2, wc = wid & 3, fr = lane & 15, fq = lane >> 4;
    const int pn = u.pn & 15; const bool pass2 = (u.pn >> 4) != 0;
    const bf16_t* gate = (const bf16_t*)(ws + (pass2 ? OFF_GA : OFF_GB)); bf16_t* dst = pass2 ? mixb : tmpb;
#pragma unroll
    for (int ai = 0; ai < 2; ++ai)
#pragma unroll
      for (int m = 0; m < 4; ++m) { asm volatile("" ::: "memory");
        const long row = (long)u.pm * 256 + 128 * ai + 64 * wr + 16 * m + fr;
#pragma unroll
        for (int bj = 0; bj < 2; ++bj) {
          const long off = row * 1024 + pn * 256 + 128 * bj + 32 * wc + 8 * fq;
          const u32x4 g4 = *(const u32x4*)(gate + off);
          f32x4 v0 = unpk4((u32x2){g4.x, g4.y}) * acc[ai][bj][m][0], v1 = unpk4((u32x2){g4.z, g4.w}) * acc[ai][bj][m][1];
          if (pass2) { const u32x4 t4 = *(const u32x4*)(tmpb + off); v0 += unpk4((u32x2){t4.x, t4.y}); v1 += unpk4((u32x2){t4.z, t4.w}); }
          const u32x2 h0 = pk4(v0), h1 = pk4(v1);
          *(u32x4*)(dst + off) = (u32x4){h0.x, h0.y, h1.x, h1.y};
        }
      }
  }
};
DI void phase_merge(const Params& p, LAS unsigned char* shm, bool dry = false) {
  const SeqMerge seq{p, dry ? (bf16_t*)p.out : (bf16_t*)(p.ws + OFF_GB), dry ? (bf16_t*)((unsigned char*)p.out + 64 * MiB) : (bf16_t*)(p.ws + OFF_GA)};
  gemm_stream(seq, shm);
}

struct SeqWo {
  const Params& p; LAS unsigned char* shm;
  DI bool get(int i, GUnit& u) const {
    int pm, pn;
    if (!tile_map(i, 128, 4, pm, pn)) return false;
    u.Ap = (const bf16_t*)(p.ws + OFF_GA) + (long)pm * 256 * 1024; u.Bp = (const bf16_t*)(p.ws + OFF_WO) + (long)pn * 256 * 1024;
    u.lda = 1024; u.ldb = 1024; u.ksa = 64; u.ksb = 64; u.nt = 16; u.pm = pm; u.pn = pn; u.permB = 0;
    return true;
  }
  DI void epi(f32x4 (&acc)[2][2][4][2], const GUnit& u) const {
    unsigned char* ws = p.ws;
    int tid_ = threadIdx.x; asm volatile("" : "+v"(tid_)); const int tid = tid_, wid = tid >> 6, lane = tid & 63, wr = wid >> 2, wc = wid & 3, fr = lane & 15, fq = lane >> 4;
    LAS float* red = (LAS float*)(shm + 131072);
    const int pm = u.pm, pn = u.pn;
#pragma unroll
    for (int ai = 0; ai < 2; ++ai)
#pragma unroll
      for (int m = 0; m < 4; ++m) { asm volatile("" ::: "memory");
        const int rl = 128 * ai + 64 * wr + 16 * m + fr;
        const long row = (long)pm * 256 + rl;
        float ss = 0.f;
#pragma unroll
        for (int bj = 0; bj < 2; ++bj) {
          const long off = row * 1024 + pn * 256 + 128 * bj + 32 * wc + 8 * fq;
          const f32x4 v0 = *(const f32x4*)(p.x + off) + acc[ai][bj][m][0], v1 = *(const f32x4*)(p.x + off + 4) + acc[ai][bj][m][1];
          *(f32x4*)(p.out + off) = v0; *(f32x4*)(p.out + off + 4) = v1;
          const u32x2 h0 = pk4(v0), h1 = pk4(v1);
          *(u32x4*)((bf16_t*)(ws + OFF_X1B) + off) = (u32x4){h0.x, h0.y, h1.x, h1.y};
          ss += ((v0[0] * v0[0] + v0[1] * v0[1]) + (v0[2] * v0[2] + v0[3] * v0[3])) + ((v1[0] * v1[0] + v1[1] * v1[1]) + (v1[2] * v1[2] + v1[3] * v1[3]));
        }
        ss += __shfl_xor(ss, 16); ss += __shfl_xor(ss, 32);
        if (fq == 0) red[wc * 256 + rl] = ss;
      }
    __syncthreads();
    if (tid < 256) ((float*)(ws + OFF_SSQ))[((long)pm * 256 + tid) * 4 + pn] = (red[tid] + red[256 + tid]) + (red[512 + tid] + red[768 + tid]);
    __syncthreads();
  }
};
DI void phase_wo(const Params& p, LAS unsigned char* shm) {
  const SeqWo seq{p, shm};
  gemm_stream(seq, shm);
}

DI void epi_gu(const Params& p, f32x4 (&acc)[2][2][4][2], int pm, int pn, int emode = 0) {
  unsigned char* ws = p.ws;
  int tid_ = threadIdx.x; asm volatile("" : "+v"(tid_)); const int tid = tid_, wid = tid >> 6, lane = tid & 63, wr = wid >> 2, wc = wid & 3, fr = lane & 15, fq = lane >> 4;
  const float* ssq = (const float*)(ws + OFF_SSQ);
  float rsr[2][4];
#pragma unroll
  for (int ai = 0; ai < 2; ++ai)
#pragma unroll
    for (int m = 0; m < 4; ++m) { const long row = (long)pm * 256 + 128 * ai + 64 * wr + 16 * m + fr;
      const f32x4 s4 = *(const f32x4*)(ssq + row * 4);
      rsr[ai][m] = __builtin_amdgcn_rsqf(((s4[0] + s4[1]) + (s4[2] + s4[3])) * (1.0f / DM) + 1e-6f); }
#pragma unroll
  for (int ai = 0; ai < 2; ++ai)
#pragma unroll
    for (int m = 0; m < 4; ++m) { asm volatile("" ::: "memory");
      const long row = (long)pm * 256 + 128 * ai + 64 * wr + 16 * m + fr;
      const float rs = rsr[ai][m];
      {
        u32x2 h[2];
#pragma unroll
        for (int n = 0; n < 2; ++n) {
          const f32x4 g = acc[ai][0][m][n] * rs, uu = acc[ai][1][m][n] * rs; f32x4 o;
#pragma unroll
          for (int j = 0; j < 4; ++j) o[j] = g[j] * sigmoidf_(g[j]) * uu[j];
          h[n] = pk4(o);
        }
        *(u32x4*)((bf16_t*)(ws + OFF_HID) + row * FH + pn * 128 + 32 * wc + 8 * fq) = (u32x4){h[0].x, h[0].y, h[1].x, h[1].y};
      }
    }
}
struct SeqGu {
  const Params& p; int emode;
  DI bool get(int i, GUnit& u) const {
    int pm, pn;
    if (!tile_map(i, 128, 22, pm, pn)) return false;
    u.Ap = (const bf16_t*)(p.ws + OFF_X1B) + (long)pm * 256 * 1024; u.Bp = (const bf16_t*)(p.ws + OFF_WGU) + (long)pn * 256 * 1024;
    u.lda = 1024; u.ldb = 1024; u.ksa = 64; u.ksb = 64; u.nt = 16; u.pm = pm; u.pn = pn; u.permB = 0;
    return true;
  }
  DI void epi(f32x4 (&acc)[2][2][4][2], const GUnit& u) const { if (emode != 2 || p.x == nullptr) epi_gu(p, acc, u.pm, u.pn, emode); }
};
DI void phase_gu(const Params& p, LAS unsigned char* shm, int emode = 0) {
  const SeqGu seq{p, emode};
  gemm_stream(seq, shm);
}

struct SeqDown {
  const Params& p; float* outw;
  DI bool get(int i, GUnit& u) const {
    int pm, pn;
    if (!tile_map(i, 128, 4, pm, pn)) return false;
    u.Ap = (const bf16_t*)(p.ws + OFF_HID) + (long)pm * 256 * FH; u.Bp = (const bf16_t*)(p.ws + OFF_WD) + (long)pn * 256 * FH;
    u.lda = FH; u.ldb = FH; u.ksa = 64; u.ksb = 64; u.nt = FH / 64; u.pm = pm; u.pn = pn; u.permB = 0;
    return true;
  }
  DI void epi(f32x4 (&acc)[2][2][4][2], const GUnit& u) const {
    int tid_ = threadIdx.x; asm volatile("" : "+v"(tid_)); const int tid = tid_, wid = tid >> 6, lane = tid & 63, wr = wid >> 2, wc = wid & 3, fr = lane & 15, fq = lane >> 4;
#pragma unroll
    for (int ai = 0; ai < 2; ++ai)
#pragma unroll
      for (int m = 0; m < 4; ++m) { asm volatile("" ::: "memory");
        const long row = (long)u.pm * 256 + 128 * ai + 64 * wr + 16 * m + fr;
#pragma unroll
        for (int bj = 0; bj < 2; ++bj)
#pragma unroll
          for (int n = 0; n < 2; ++n) {
            const long off = row * 1024 + u.pn * 256 + 128 * bj + 32 * wc + 16 * n + 4 * fq;
            *(f32x4*)(outw + off) = *(const f32x4*)(p.out + off) + acc[ai][bj][m][n];
          }
      }
  }
};
DI void phase_down(const Params& p, LAS unsigned char* shm, bool dry = false) {
  const SeqDown seq{p, dry ? (float*)(p.ws + OFF_MK) : p.out};
  gemm_stream(seq, shm);
}

#define XB_TMO      128
#define XB_XCNT(j)  (256  + 64 * (j))
#define XB_XSUB(j)  (1280 + 64 * (j))
#define XB_XGEN(j)  (2304 + 64 * (j))
#define XB_TOP      3328
#define XB_TOPGEN   3392
#define XCD_BAR_WORDS 3456
#define XB_SPIN_CAP (1u << 18)
DI unsigned xb_ld(unsigned* p) { return __hip_atomic_load(p, __ATOMIC_RELAXED, __HIP_MEMORY_SCOPE_AGENT); }
DI unsigned xb_add(unsigned* p, unsigned v) { return __hip_atomic_fetch_add(p, v, __ATOMIC_RELAXED, __HIP_MEMORY_SCOPE_AGENT); }
DI unsigned xb_xcc_id() { return (unsigned)__builtin_amdgcn_s_getreg((3 << 11) | 20) & 0xFu; }
#define XB_SPIN(cond, bar) do { unsigned _sp = 0; while (cond) { __builtin_amdgcn_s_sleep(1); \
    if ((++_sp & 255u) == 0u) { if (xb_ld(&(bar)[XB_TMO])) break; if (_sp > XB_SPIN_CAP) { atomicAdd(&(bar)[XB_TMO], 1u); break; } } } } while (0)
struct XcdBarrier { unsigned* bar; unsigned x; volatile LAS unsigned* st; };
DI XcdBarrier xcd_barrier_post(unsigned* bar, volatile LAS unsigned* st) {
  XcdBarrier b; b.bar = bar; b.x = xb_xcc_id(); b.st = st;
  if (threadIdx.x == 0) (void)xb_add(&bar[XB_XCNT(b.x)], 1u);
  return b;
}
DI void xcd_barrier_complete(unsigned* bar, unsigned x, unsigned& nloc, unsigned& nx) {
  const unsigned G = gridDim.x * gridDim.y * gridDim.z;
  unsigned sum, cnt, mine, sp = 0u;
  for (;;) {
    sum = 0u; cnt = 0u; mine = 0u;
#pragma unroll
    for (unsigned j = 0; j < 16; ++j) { const unsigned c = xb_ld(&bar[XB_XCNT(j)]); sum += c; cnt += (c > 0u) ? 1u : 0u; mine = (j == x) ? c : mine; }
    if (sum == G) break;
    __builtin_amdgcn_s_sleep(1);
    if ((++sp & 255u) == 0u) { if (xb_ld(&bar[XB_TMO])) break; if (sp > XB_SPIN_CAP) { atomicAdd(&bar[XB_TMO], 1u); break; } }
  }
  nloc = mine > 0u ? mine : 1u; nx = cnt > 0u ? cnt : 1u;
}
DI void xcd_barrier(const XcdBarrier& b) {
  asm volatile("s_waitcnt vmcnt(0)" ::: "memory");
  __syncthreads();
  if (threadIdx.x == 0) {
    unsigned* bar = b.bar;
    __builtin_amdgcn_s_waitcnt(0);
    unsigned nloc = b.st[0], nx = b.st[1];
    if (nloc == 0u) { xcd_barrier_complete(bar, b.x, nloc, nx); b.st[0] = nloc; b.st[1] = nx; }
    const unsigned old = xb_add(&bar[XB_XSUB(b.x)], 1u);
    const unsigned gen = old / nloc;
    if (old + 1u == (gen + 1u) * nloc) {
      __builtin_amdgcn_fence(__ATOMIC_RELEASE, "agent");
      asm volatile("s_waitcnt vmcnt(0)" ::: "memory");
      const unsigned og = xb_add(&bar[XB_TOP], 1u);
      const unsigned tg = og / nx;
      if (og + 1u == (tg + 1u) * nx) xb_add(&bar[XB_TOPGEN], 1u);
      else XB_SPIN(xb_ld(&bar[XB_TOPGEN]) == tg, bar);
      __builtin_amdgcn_fence(__ATOMIC_ACQUIRE, "agent");
      xb_add(&bar[XB_XGEN(b.x)], 1u);
      asm volatile("s_waitcnt vmcnt(0)" ::: "memory");
    } else {
      XB_SPIN(xb_ld(&bar[XB_XGEN(b.x)]) == gen, bar);
      __builtin_amdgcn_fence(__ATOMIC_ACQUIRE, "agent");
      asm volatile("s_waitcnt vmcnt(0)" ::: "memory");
    }
  }
  __syncthreads();
}

__global__ void __launch_bounds__(NTHREADS) fwd_megakernel(Params p) {
  extern __shared__ __attribute__((aligned(16))) unsigned char shm_raw[];
  LAS unsigned char* shm = (LAS unsigned char*)shm_raw;
  cg::grid_group grid = cg::this_grid();
  volatile LAS unsigned* xst = (volatile LAS unsigned*)(shm + LDS_BYTES - 16);
  if (threadIdx.x == 0) { xst[0] = 0u; xst[1] = 0u; }
  unsigned* bar = (unsigned*)(p.ws + OFF_BAR);
  __syncthreads();
  const XcdBarrier xb = xcd_barrier_post(bar, xst);
  phase0(p, shm);
  if (p.x == nullptr) grid.sync();
  xcd_barrier(xb);
  phase1(p, shm);
  xcd_barrier(xb);
  ret_scan(p, shm);
  moba_phase(p, shm);
  xcd_barrier(xb);
  ret_out_phase(p, shm);
  xcd_barrier(xb);
  phase_merge(p, shm);
  xcd_barrier(xb);
  phase_wo(p, shm);
  xcd_barrier(xb);
  phase_gu(p, shm);
  xcd_barrier(xb);
  phase_down(p, shm);
}

extern "C" void kernel_launch(void* const* d_in, const int* in_sizes, int n_in, void* d_out, int out_size, void* d_ws, size_t ws_size, hipStream_t stream) {
  static int grid_blocks = 0;
  if (grid_blocks == 0) {
    if (n_in != 12 || out_size != T_TOK * DM || ws_size < WS_END) { fprintf(stderr, "kernel_launch: unexpected shapes / workspace (n_in %d out %d ws %zu need %zu)\n", n_in, out_size, ws_size, (size_t)WS_END); grid_blocks = -1; return; }
    int dev = 0, cus = 0, per_cu = 0;
    hipGetDevice(&dev);
    hipDeviceGetAttribute(&cus, hipDeviceAttributeMultiprocessorCount, dev);
    if (hipFuncSetAttribute((const void*)fwd_megakernel, hipFuncAttributeMaxDynamicSharedMemorySize, LDS_BYTES) != hipSuccess) { fprintf(stderr, "hipFuncSetAttribute failed\n"); grid_blocks = -1; return; }
    hipOccupancyMaxActiveBlocksPerMultiprocessor(&per_cu, (const void*)fwd_megakernel, NTHREADS, LDS_BYTES);
    if (per_cu < 1) { fprintf(stderr, "occupancy query says %d blocks/CU\n", per_cu); per_cu = 1; }
    if (per_cu > 1) per_cu = 1;
    grid_blocks = cus * per_cu;
  }
  if (grid_blocks < 0) return;
  Params p{};
  p.x = (const float*)d_in[0]; p.norm1_w = (const float*)d_in[1]; p.w_in = (const float*)d_in[2]; p.q_norm_w = (const float*)d_in[3]; p.k_norm_w = (const float*)d_in[4];
  p.w_ret_out = (const float*)d_in[5]; p.w_moba_out = (const float*)d_in[6]; p.w_o = (const float*)d_in[7]; p.norm2_w = (const float*)d_in[8];
  p.w_gate = (const float*)d_in[9]; p.w_up = (const float*)d_in[10]; p.w_down = (const float*)d_in[11];
  p.out = (float*)d_out; p.ws = (unsigned char*)d_ws;
  void* args[] = {&p};
  if (hipMemsetAsync((unsigned char*)d_ws + OFF_BAR, 0, 16384, stream) != hipSuccess) { fprintf(stderr, "hipMemsetAsync of the barrier words failed\n"); return; }
  hipError_t e = hipLaunchCooperativeKernel((const void*)fwd_megakernel, dim3(grid_blocks), dim3(NTHREADS), args, LDS_BYTES, stream);
  if (e != hipSuccess) fprintf(stderr, "cooperative launch failed: %s (grid %d)\n", hipGetErrorString(e), grid_blocks);
}
```

```cpp
#include <hip/hip_runtime.h>
#include <hip/hip_cooperative_groups.h>
#include <cstdio>
#include <cstdint>
#include <type_traits>
namespace cg = cooperative_groups;

#define DI __device__ __forceinline__
#define LAS __attribute__((address_space(3)))
typedef unsigned short bf16_t;
typedef short bf16x8 __attribute__((ext_vector_type(8)));
typedef float f32x4 __attribute__((ext_vector_type(4)));
typedef float f32x2 __attribute__((ext_vector_type(2)));
typedef __bf16 bf16v2 __attribute__((ext_vector_type(2)));
typedef unsigned u32x2 __attribute__((ext_vector_type(2)));
typedef unsigned u32x4 __attribute__((ext_vector_type(4)));

constexpr int T_TOK = 32768, SEQ = 8192, DM = 1024, NCOL = 6656, FH = 2816;
constexpr int NTHREADS = 512;
constexpr int LDS_BYTES = 147456;
constexpr size_t MiB = 1048576;
constexpr size_t OFF_WIN = 0;
constexpr size_t OFF_WRO = OFF_WIN + 13 * MiB;
constexpr size_t OFF_WMO = OFF_WRO + 2 * MiB;
constexpr size_t OFF_WO  = OFF_WMO + 1 * MiB;
constexpr size_t OFF_WGU = OFF_WO + 2 * MiB;
constexpr size_t OFF_WD  = OFF_WGU + 11 * MiB;
constexpr size_t OFF_QR  = OFF_WD + 6 * MiB;
constexpr size_t OFF_KR  = OFF_QR + 32 * MiB;
constexpr size_t OFF_KRT = OFF_KR + 32 * MiB;
constexpr size_t OFF_VRT = OFF_KRT + 32 * MiB;
constexpr size_t OFF_G   = OFF_VRT + 64 * MiB;
constexpr size_t OFF_MQ  = OFF_G + 64 * MiB;
constexpr size_t OFF_MK  = OFF_MQ + 32 * MiB;
constexpr size_t OFF_MVT = OFF_MK + 32 * MiB;
constexpr size_t OFF_GA  = OFF_MVT + 32 * MiB;
constexpr size_t OFF_GB  = OFF_GA + 64 * MiB;
constexpr size_t OFF_MISC = OFF_GB + 64 * MiB;
constexpr size_t OFF_COS = OFF_MISC;
constexpr size_t OFF_SIN = OFF_COS + 2 * MiB;
constexpr size_t OFF_RSTD1 = OFF_SIN + 2 * MiB;
constexpr size_t OFF_SSQ = OFF_RSTD1 + 131072;
constexpr size_t OFF_KBAR = OFF_SSQ + 4 * 131072;
constexpr size_t OFF_SC = OFF_KBAR + 262144;
constexpr size_t OFF_BAR = OFF_SC + 4096;
constexpr size_t OFF_RSTD1Q = OFF_BAR + 16384;
constexpr size_t WS_END = OFF_RSTD1Q + 131072;
constexpr size_t OFF_X1B = OFF_QR;
constexpr size_t OFF_HID = OFF_KRT;

struct Params {
  const float *x, *norm1_w, *w_in, *q_norm_w, *k_norm_w, *w_ret_out, *w_moba_out, *w_o, *norm2_w, *w_gate, *w_up, *w_down;
  float* out;
  unsigned char* ws;
};

DI unsigned pk2(float lo, float hi) { f32x2 v = {lo, hi}; bf16v2 b = __builtin_convertvector(v, bf16v2); return __builtin_bit_cast(unsigned, b); }
DI bf16_t f2bf(float x) { return (bf16_t)(pk2(x, 0.f) & 0xffffu); }
DI u32x2 pk4(f32x4 v) { u32x2 r; r.x = pk2(v[0], v[1]); r.y = pk2(v[2], v[3]); return r; }
DI float bf2f(bf16_t v) { return __uint_as_float(((unsigned)v) << 16); }
DI f32x4 unpk4(u32x2 u) { f32x4 r; r[0] = __uint_as_float(u.x << 16); r[1] = __uint_as_float(u.x & 0xffff0000u); r[2] = __uint_as_float(u.y << 16); r[3] = __uint_as_float(u.y & 0xffff0000u); return r; }
DI float lg2gamma(int h) { return h == 0 ? -0.045803689613124f : (h == 1 ? -0.022720076500083f : (h == 2 ? -0.011315313227834f : -0.005646563141142f)); }
DI float fast_exp2(float x) { return __builtin_amdgcn_exp2f(x); }
DI float sigmoidf_(float v) { return __builtin_amdgcn_rcpf(1.f + fast_exp2(-1.4426950408889634f * v)); }
#define MFMA16(a, b, c) __builtin_amdgcn_mfma_f32_16x16x32_bf16((a), (b), (c), 0, 0, 0)

DI int lds_byte(int r, int c) { const int st = (r >> 4) * 2 + (c >> 5), rr = r & 15, cc = c & 31, ob = rr * 64 + cc * 2; return st * 1024 + (ob ^ (((ob >> 9) & 1) << 5)); }
DI void stage_rc(int b, int& R, int& C) { const int st = b / 1024, sb = b % 1024, swz = sb ^ (((sb >> 9) & 1) << 5); R = (st >> 1) * 16 + swz / 64; C = (st & 1) * 32 + (swz % 64) / 2; }
DI void glds16(const bf16_t* g, LAS unsigned char* l) {
  __builtin_amdgcn_global_load_lds((const __attribute__((address_space(1))) unsigned*)g, (LAS unsigned*)l, 16, 0, 0);
}

DI void gemm_main(const bf16_t* Ap, long lda, long ksa, const bf16_t* Bp, long ldb, long ksb, int nt, LAS unsigned char* shm, f32x4 (&acc)[2][2][4][2], const bool pre = false) {
  int tid_ = threadIdx.x; asm volatile("" : "+v"(tid_)); const int tid = tid_, wid = __builtin_amdgcn_readfirstlane(tid >> 6), lane = tid & 63, wr = wid >> 2, wc = wid & 3, fr = lane & 15, fq = lane >> 4;
  int voffA[2], voffB[2];
#pragma unroll
  for (int i = 0; i < 2; ++i) { int R, C; stage_rc(tid * 16 + i * 8192, R, C); voffA[i] = R * (int)lda + C; voffB[i] = R * (int)ldb + C; }
  const int aoff = lds_byte(wr * 64 + fr, fq * 8), boff = lds_byte(wc * 32 + fr, fq * 8);
  LAS unsigned char* ldsw = shm + wid * 1024;
  const long hA = 128 * lda, hB = 128 * ldb;
#pragma unroll
  for (int ai = 0; ai < 2; ++ai)
#pragma unroll
    for (int bj = 0; bj < 2; ++bj)
#pragma unroll
      for (int m = 0; m < 4; ++m)
#pragma unroll
        for (int n = 0; n < 2; ++n) acc[ai][bj][m][n] = (f32x4){0.f, 0.f, 0.f, 0.f};
  bf16x8 At[4][2], B0[2][2], B1[2][2];
#define G_SA(b, h) (((b) * 2 + (h)) * 16384)
#define G_SB(b, h) ((4 + (b) * 2 + (h)) * 16384)
#define G_STAGE(bufoff, gp, voff) do { const bf16_t* gp_ = (gp); glds16(gp_ + (voff)[0], ldsw + (bufoff)); glds16(gp_ + (voff)[1], ldsw + (bufoff) + 8192); } while (0)
#define G_A0(kt) (Ap + (long)(kt) * ksa)
#define G_A1(kt) (Ap + hA + (long)(kt) * ksa)
#define G_B0(kt) (Bp + (long)(kt) * ksb)
#define G_B1(kt) (Bp + hB + (long)(kt) * ksb)
#define G_LDA(dst, b, h) do { _Pragma("unroll") for (int m = 0; m < 4; ++m) _Pragma("unroll") for (int k = 0; k < 2; ++k) dst[m][k] = *(const LAS bf16x8*)(shm + G_SA(b, h) + aoff + m * 2048 + k * 1024); } while (0)
#define G_LDB(dst, b, h) do { _Pragma("unroll") for (int n = 0; n < 2; ++n) _Pragma("unroll") for (int k = 0; k < 2; ++k) dst[n][k] = *(const LAS bf16x8*)(shm + G_SB(b, h) + boff + n * 2048 + k * 1024); } while (0)
#define G_MMA(ai, bj, A_, B_) do { __builtin_amdgcn_s_setprio(1); _Pragma("unroll") for (int m = 0; m < 4; ++m) _Pragma("unroll") for (int n = 0; n < 2; ++n) _Pragma("unroll") for (int k = 0; k < 2; ++k) \
    acc[ai][bj][m][n] = MFMA16(B_[n][k], A_[m][k], acc[ai][bj][m][n]); __builtin_amdgcn_s_setprio(0); } while (0)
#define G_WAIT_V(n) asm volatile("s_waitcnt vmcnt(" #n ")" ::: "memory")
#define G_WAIT_L(n) asm volatile("s_waitcnt lgkmcnt(" #n ")" ::: "memory")
#define G_BAR __builtin_amdgcn_s_barrier()
#define G_SCHED __builtin_amdgcn_sched_barrier(0)
  G_WAIT_V(0);
  if (!pre) {
    G_STAGE(G_SB(0, 0), G_B0(0), voffB); G_STAGE(G_SA(0, 0), G_A0(0), voffA); G_STAGE(G_SB(0, 1), G_B1(0), voffB); G_STAGE(G_SA(0, 1), G_A1(0), voffA);
    if (wr == 1) G_BAR;
    G_WAIT_V(4); G_BAR;
    G_STAGE(G_SB(1, 0), G_B0(1), voffB); G_STAGE(G_SA(1, 0), G_A0(1), voffA); G_STAGE(G_SB(1, 1), G_B1(1), voffB);
    G_WAIT_V(6); G_BAR;
  } else {
    if (wr == 1) G_BAR;
    G_BAR; G_BAR;
  }
#pragma unroll 1
  for (int t = 0; t < nt - 2; t += 2) {
    G_LDB(B0, 0, 0); G_SCHED; G_LDA(At, 0, 0); G_STAGE(G_SA(1, 1), G_A1(t + 1), voffA);
    G_WAIT_L(8); G_BAR; G_WAIT_L(0); G_MMA(0, 0, At, B0); G_BAR; G_SCHED;
    G_LDB(B1, 0, 1); G_STAGE(G_SB(0, 0), G_B0(t + 2), voffB);
    G_BAR; G_WAIT_L(0); G_MMA(0, 1, At, B1); G_BAR;
    G_LDA(At, 0, 1); G_STAGE(G_SA(0, 0), G_A0(t + 2), voffA);
    G_BAR; G_WAIT_L(0); G_MMA(1, 0, At, B0); G_BAR; G_SCHED;
    G_STAGE(G_SB(0, 1), G_B1(t + 2), voffB);
    G_WAIT_V(6); G_BAR; G_MMA(1, 1, At, B1); G_BAR;
    G_LDB(B0, 1, 0); G_SCHED; G_LDA(At, 1, 0); G_STAGE(G_SA(0, 1), G_A1(t + 2), voffA);
    G_WAIT_L(8); G_BAR; G_WAIT_L(0); G_MMA(0, 0, At, B0); G_BAR; G_SCHED;
    G_LDB(B1, 1, 1); G_STAGE(G_SB(1, 0), G_B0(t + 3), voffB);
    G_BAR; G_WAIT_L(0); G_MMA(0, 1, At, B1); G_BAR;
    G_LDA(At, 1, 1); G_STAGE(G_SA(1, 0), G_A0(t + 3), voffA);
    G_BAR; G_WAIT_L(0); G_MMA(1, 0, At, B0); G_BAR; G_SCHED;
    G_STAGE(G_SB(1, 1), G_B1(t + 3), voffB);
    G_WAIT_V(6); G_BAR; G_MMA(1, 1, At, B1); G_BAR;
  }
  { G_LDB(B0, 0, 0); G_LDA(At, 0, 0); G_STAGE(G_SA(1, 1), G_A1(nt - 1), voffA);
    G_BAR; G_WAIT_L(0); G_MMA(0, 0, At, B0); G_BAR;
    G_LDB(B1, 0, 1); G_BAR; G_WAIT_L(0); G_MMA(0, 1, At, B1); G_BAR;
    G_LDA(At, 0, 1); G_WAIT_V(4); G_BAR; G_WAIT_L(0); G_MMA(1, 0, At, B0); G_MMA(1, 1, At, B1); G_BAR; }
  { G_LDB(B0, 1, 0); G_LDA(At, 1, 0); G_WAIT_V(2); G_BAR; G_WAIT_L(0); G_MMA(0, 0, At, B0); G_BAR;
    G_LDB(B1, 1, 1); G_WAIT_V(0); G_BAR; G_WAIT_L(0); G_MMA(0, 1, At, B1); G_BAR;
    G_LDA(At, 1, 1); G_BAR; G_WAIT_L(0); G_MMA(1, 0, At, B0); G_MMA(1, 1, At, B1); G_BAR; }
  if (wr == 0) G_BAR;
  asm volatile("" ::: "memory");
}

DI void gemm_prefetch(const bf16_t* Ap, long lda, long ksa, const bf16_t* Bp, long ldb, long ksb, LAS unsigned char* shm) {
  int tid_ = threadIdx.x; asm volatile("" : "+v"(tid_)); const int tid = tid_, wid = __builtin_amdgcn_readfirstlane(tid >> 6);
  int voffA[2], voffB[2];
#pragma unroll
  for (int i = 0; i < 2; ++i) { int R, C; stage_rc(tid * 16 + i * 8192, R, C); voffA[i] = R * (int)lda + C; voffB[i] = R * (int)ldb + C; }
  LAS unsigned char* ldsw = shm + wid * 1024;
  const long hA = 128 * lda, hB = 128 * ldb;
  G_STAGE(G_SB(0, 0), G_B0(0), voffB); G_STAGE(G_SA(0, 0), G_A0(0), voffA); G_STAGE(G_SB(0, 1), G_B1(0), voffB); G_STAGE(G_SA(0, 1), G_A1(0), voffA);
  G_STAGE(G_SB(1, 0), G_B0(1), voffB); G_STAGE(G_SA(1, 0), G_A0(1), voffA); G_STAGE(G_SB(1, 1), G_B1(1), voffB);
}

struct GUnit { const bf16_t* Ap; const bf16_t* Bp; int lda, ldb; long ksa, ksb; int nt, pm, pn, permB; };
#define G_STAGE2(bufoff, gp, v0, v1) do { const bf16_t* gp_ = (gp); glds16(gp_ + (v0), ldsw + (bufoff)); glds16(gp_ + (v1), ldsw + (bufoff) + 8192); } while (0)
template <class Seq>
DI void gemm_stream(const Seq& seq, LAS unsigned char* shm, const bool pre = false, const bool has_tail = false, const GUnit tail = GUnit{}) {
  int tid_ = threadIdx.x; asm volatile("" : "+v"(tid_)); const int tid = tid_, wid = __builtin_amdgcn_readfirstlane(tid >> 6), lane = tid & 63, wr = wid >> 2, wc = wid & 3, fr = lane & 15, fq = lane >> 4;
  int R0, C0, R1, C1; stage_rc(tid * 16, R0, C0); stage_rc(tid * 16 + 8192, R1, C1);
  const int aoff = lds_byte(wr * 64 + fr, fq * 8), boff = lds_byte(wc * 32 + fr, fq * 8);
  LAS unsigned char* ldsw = shm + wid * 1024;
  GUnit cur, nxt;
  if (!seq.get(0, cur)) return;
  f32x4 acc[2][2][4][2];
#pragma unroll
  for (int ai = 0; ai < 2; ++ai)
#pragma unroll
    for (int bj = 0; bj < 2; ++bj)
#pragma unroll
      for (int m = 0; m < 4; ++m)
#pragma unroll
        for (int n = 0; n < 2; ++n) acc[ai][bj][m][n] = (f32x4){0.f, 0.f, 0.f, 0.f};
  bf16x8 At[4][2], B0[2][2], B1[2][2];
  const int P0 = (R0 & ~31) + 8 * ((R0 & 15) >> 2) + 4 * ((R0 >> 4) & 1) + (R0 & 3), P1 = (R1 & ~31) + 8 * ((R1 & 15) >> 2) + 4 * ((R1 >> 4) & 1) + (R1 & 3);
  int va0 = R0 * cur.lda + C0, va1 = R1 * cur.lda + C1, vb0 = (cur.permB ? P0 : R0) * cur.ldb + C0, vb1 = (cur.permB ? P1 : R1) * cur.ldb + C1;
  G_WAIT_V(0);
  if (pre) { if (wr == 1) G_BAR; G_BAR; G_BAR; }
  else {
    const bf16_t* Ap = cur.Ap; const bf16_t* Bp = cur.Bp; const long hA = 128L * cur.lda, hB = 128L * cur.ldb;
    G_STAGE2(G_SB(0, 0), Bp, vb0, vb1); G_STAGE2(G_SB(0, 1), Bp + hB, vb0, vb1); G_STAGE2(G_SA(0, 0), Ap, va0, va1); G_STAGE2(G_SA(0, 1), Ap + hA, va0, va1);
    if (wr == 1) G_BAR;
    G_WAIT_V(2); G_BAR;
    G_STAGE2(G_SB(1, 0), Bp + cur.ksb, vb0, vb1); G_STAGE2(G_SA(1, 0), Ap + cur.ksa, va0, va1); G_STAGE2(G_SB(1, 1), Bp + hB + cur.ksb, vb0, vb1);
    G_WAIT_V(6); G_BAR;
  }
  for (int ui = 0;; ++ui) {
    const bool has_next = seq.get(ui + 1, nxt);
    if (!has_next) nxt = has_tail ? tail : cur;
    const int na0 = R0 * nxt.lda + C0, na1 = R1 * nxt.lda + C1, nb0 = (nxt.permB ? P0 : R0) * nxt.ldb + C0, nb1 = (nxt.permB ? P1 : R1) * nxt.ldb + C1;
    const long hA = 128L * cur.lda, hB = 128L * cur.ldb, nhA = 128L * nxt.lda, nhB = 128L * nxt.ldb;
    const int nt = cur.nt;
#pragma unroll 1
    for (int t = 0; t < nt; t += 2) {
      const bool last = t == nt - 2;
      const bf16_t* a1 = cur.Ap + (long)(t + 1) * cur.ksa;
      const bf16_t* a2 = last ? nxt.Ap : cur.Ap + (long)(t + 2) * cur.ksa; const bf16_t* b2 = last ? nxt.Bp : cur.Bp + (long)(t + 2) * cur.ksb;
      const bf16_t* a3 = a2 + (last ? nxt.ksa : cur.ksa); const bf16_t* b3 = b2 + (last ? nxt.ksb : cur.ksb);
      const long h2A = last ? nhA : hA, h2B = last ? nhB : hB;
      const int xa0 = last ? na0 : va0, xa1 = last ? na1 : va1, xb0 = last ? nb0 : vb0, xb1 = last ? nb1 : vb1;
      G_LDB(B0, 0, 0); G_LDB(B1, 0, 1); G_SCHED; G_LDA(At, 0, 0); G_STAGE2(G_SA(1, 1), a1 + hA, va0, va1);
      G_WAIT_V(8); G_WAIT_L(0); G_BAR; G_MMA(0, 0, At, B0); G_MMA(0, 1, At, B1); G_BAR; G_SCHED;
      G_LDA(At, 0, 1); G_STAGE2(G_SB(0, 0), b2, xb0, xb1); G_STAGE2(G_SB(0, 1), b2 + h2B, xb0, xb1); G_STAGE2(G_SA(0, 0), a2, xa0, xa1);
      G_WAIT_V(8); G_WAIT_L(0); G_BAR; G_MMA(1, 0, At, B0); G_MMA(1, 1, At, B1); G_BAR; G_SCHED;
      G_LDB(B0, 1, 0); G_LDB(B1, 1, 1); G_SCHED; G_LDA(At, 1, 0); G_STAGE2(G_SA(0, 1), a2 + h2A, xa0, xa1);
      G_WAIT_V(8); G_WAIT_L(0); G_BAR; G_MMA(0, 0, At, B0); G_MMA(0, 1, At, B1); G_BAR; G_SCHED;
      G_LDA(At, 1, 1); G_STAGE2(G_SB(1, 0), b3, xb0, xb1); G_STAGE2(G_SB(1, 1), b3 + h2B, xb0, xb1); G_STAGE2(G_SA(1, 0), a3, xa0, xa1);
      G_WAIT_V(8); G_WAIT_L(0); G_BAR; G_MMA(1, 0, At, B0); G_MMA(1, 1, At, B1); G_BAR; G_SCHED;
    }
    if (wr == 0) G_BAR;
    asm volatile("" ::: "memory");
    seq.epi(acc, cur);
    if (!has_next) break;
#pragma unroll
    for (int ai = 0; ai < 2; ++ai)
#pragma unroll
      for (int bj = 0; bj < 2; ++bj)
#pragma unroll
        for (int m = 0; m < 4; ++m)
#pragma unroll
          for (int n = 0; n < 2; ++n) acc[ai][bj][m][n] = (f32x4){0.f, 0.f, 0.f, 0.f};
    cur = nxt; va0 = na0; va1 = na1; vb0 = nb0; vb1 = nb1;
    if (wr == 1) G_BAR;
  }
  G_WAIT_V(0);
  __syncthreads();
}

DI bool tile_map(int i, int nM, int nN, int& pm, int& pn) {
  const int G = gridDim.x, c = blockIdx.x;
  if ((G & 7) == 0 && (nM & 63) == 0) {
    const int x = c & 7, loc = c >> 3, per = G >> 3, q = i * per + loc, total = (nM >> 3) * nN;
    if (q >= total) return false;
    const int g = q / (8 * nN), r = q % (8 * nN);
    pm = 8 * (g * 8 + (r & 7)) + x; pn = r >> 3; return true;
  }
  const long L = (long)i * G + c; if (L >= (long)nM * nN) return false;
  pm = (int)(L / nN); pn = (int)(L % nN); return true;
}

template <int MODE>
DI void conv_item(const float* src, const float* src2, const float* rs, bf16_t* dst, int K, int Nsrc, int nblk, LAS float* scr, int item, int lane) {
  const int kb = item / nblk, nb = item % nblk, k0 = 64 * kb, n0 = 32 * nb;
  const int n = n0 + (lane & 31);
  int col = n; float cs = 1.f; const float* s = src;
  if (MODE == 0) {
    if (n < 1024) { const int head = n >> 7, pp = n & 127, half = (pp >> 4) & 1, jj = pp >> 5, i = pp & 15; col = head * 128 + half * 64 + jj * 16 + i; if (n >= 512) cs = 0.08838834764831845f; }
    else if (n >= 3072 && n < 4096) { const int c = (n - 3072) & 255, base = n - c; col = base + 64 * ((c >> 5) & 3) + 32 * (c >> 7) + 8 * ((c & 15) >> 2) + 4 * ((c >> 4) & 1) + (c & 3); }
    else if ((n >= 2048 && n < 3072) || n >= 4608) { const int rho = n & 31; col = (n & ~31) + 8 * ((rho & 15) >> 2) + 4 * (rho >> 4) + (rho & 3); }
  } else if (MODE == 3) {
    const int rho = n & 31; col = (n & ~31) + 8 * ((rho & 15) >> 2) + 4 * (rho >> 4) + (rho & 3);
  } else if (MODE == 1) {
    const int c = n & 255, r7 = c & 127, rho = r7 & 31; col = (n >> 8) * 128 + (r7 & ~31) + 8 * ((rho & 15) >> 2) + 4 * (rho >> 4) + (rho & 3); if (c >> 7) s = src2;
  }
  const float* sp = s + (long)(k0 + (lane >> 5)) * Nsrc + col;
#pragma unroll 8
  for (int i = 0; i < 32; ++i) {
    const int kk = 2 * i + (lane >> 5);
    float w = sp[(long)(2 * i) * Nsrc] * cs;
    if (rs) w *= rs[k0 + kk];
    scr[kk * 33 + (lane & 31)] = w;
  }
  asm volatile("s_waitcnt lgkmcnt(0)" ::: "memory");
  const int c = lane & 7;
#pragma unroll
  for (int j = 0; j < 4; ++j) {
    const int nn = (lane >> 3) + 8 * j; const LAS float* q = scr + (8 * c) * 33 + nn;
    u32x4 o; o.x = pk2(q[0], q[33]); o.y = pk2(q[2 * 33], q[3 * 33]); o.z = pk2(q[4 * 33], q[5 * 33]); o.w = pk2(q[6 * 33], q[7 * 33]);
    *(u32x4*)(dst + (long)(n0 + nn) * K + k0 + 8 * c) = o;
  }
  asm volatile("s_waitcnt lgkmcnt(0)" ::: "memory");
}

DI void phase0(const Params& p, LAS unsigned char* shm, int part = 7) {
  unsigned char* ws = p.ws;
  const long gtid = (long)blockIdx.x * NTHREADS + threadIdx.x, nthr = (long)gridDim.x * NTHREADS;
  const int lane = threadIdx.x & 63, wv = threadIdx.x >> 6, gw = blockIdx.x * 8 + wv, ngw = gridDim.x * 8;
  if (part & 1) {
    bf16_t* xb = (bf16_t*)((unsigned char*)p.out + 64 * MiB);
    float* rstd1 = (float*)(ws + OFF_RSTD1);
    for (int r0 = gw * 4; r0 < T_TOK; r0 += ngw * 4) {
      f32x4 v[4][4];
#pragma unroll
      for (int rr = 0; rr < 4; ++rr) {
        const f32x4* xr = (const f32x4*)(p.x + (long)(r0 + rr) * DM) + lane;
#pragma unroll
        for (int j = 0; j < 4; ++j) v[rr][j] = xr[64 * j];
      }
#pragma unroll
      for (int rr = 0; rr < 4; ++rr) {
        float s = 0.f;
#pragma unroll
        for (int j = 0; j < 4; ++j) s += v[rr][j][0] * v[rr][j][0] + v[rr][j][1] * v[rr][j][1] + v[rr][j][2] * v[rr][j][2] + v[rr][j][3] * v[rr][j][3];
#pragma unroll
        for (int o = 1; o < 64; o <<= 1) s += __shfl_xor(s, o);
        if (lane == 0) { const float rv = 1.0f / sqrtf(s * (1.0f / DM) + 1e-6f); const int r = r0 + rr, rl = r & 255;
          rstd1[r] = rv; ((float*)(ws + OFF_RSTD1Q))[(r & ~255) + (((rl >> 6) & 1) * 16 + (rl & 15)) * 8 + (rl >> 7) * 4 + ((rl >> 4) & 3)] = rv; }
        u32x2* o8 = (u32x2*)(xb + (long)(r0 + rr) * DM) + lane;
#pragma unroll
        for (int j = 0; j < 4; ++j) o8[64 * j] = pk4(v[rr][j]);
      }
    }
  }
  if (part & 2) {
    LAS float* scr = (LAS float*)shm + wv * (64 * 33);
    constexpr int I0 = 16 * 208, I1 = 16 * 32, I2 = 8 * 32, I3 = 16 * 32, I4 = 16 * 176, I5 = 44 * 32;
    for (int it = gw; it < I0 + I1 + I2 + I3 + I4 + I5; it += ngw) {
      int r = it;
      if (r < I0) { conv_item<0>(p.w_in, nullptr, p.norm1_w, (bf16_t*)(ws + OFF_WIN), 1024, NCOL, 208, scr, r, lane); continue; } r -= I0;
      if (r < I1) { conv_item<3>(p.w_ret_out, nullptr, nullptr, (bf16_t*)(ws + OFF_WRO), 1024, 1024, 32, scr, r, lane); continue; } r -= I1;
      if (r < I2) { conv_item<3>(p.w_moba_out, nullptr, nullptr, (bf16_t*)(ws + OFF_WMO), 512, 1024, 32, scr, r, lane); continue; } r -= I2;
      if (r < I3) { conv_item<3>(p.w_o, nullptr, nullptr, (bf16_t*)(ws + OFF_WO), 1024, 1024, 32, scr, r, lane); continue; } r -= I3;
      if (r < I4) { conv_item<1>(p.w_gate, p.w_up, p.norm2_w, (bf16_t*)(ws + OFF_WGU), 1024, FH, 176, scr, r, lane); continue; } r -= I4;
      conv_item<2>(p.w_down, nullptr, nullptr, (bf16_t*)(ws + OFF_WD), FH, 1024, 32, scr, r, lane);
    }
  }
  if (part & 4) {
    float* cosT = (float*)(ws + OFF_COS); float* sinT = (float*)(ws + OFF_SIN);
    for (long idx = gtid; idx < (long)SEQ * 64; idx += nthr) {
      const int pos = (int)(idx >> 6), j = (int)(idx & 63);
      const float inv = exp2f(-(float)j * (13.287712379549449f / 64.0f));
      const float ang = (float)pos * inv;
      const double rev = (double)ang * 0.15915494309189535;
      const float fr = (float)(rev - __builtin_rint(rev));
      cosT[idx] = __builtin_amdgcn_cosf(fr); sinT[idx] = __builtin_amdgcn_sinf(fr);
    }
  }
  if (blockIdx.x == 0 && threadIdx.x < 64) {
    float a = fabsf(p.q_norm_w[threadIdx.x]), b = fabsf(p.k_norm_w[threadIdx.x]);
#pragma unroll
    for (int o = 1; o < 64; o <<= 1) { a = fmaxf(a, __shfl_xor(a, o)); b = fmaxf(b, __shfl_xor(b, o)); }
    if (threadIdx.x == 0) ((float*)(ws + OFF_SC))[0] = 8.0f * a * b * 1.01f;
  }
}

template <int REG>
DI void epi_inproj(const Params& p, f32x4 (&acc)[2][2][4][2], int pm, int pn, LAS unsigned char* shm) {
  unsigned char* ws = p.ws;
  int tid_ = threadIdx.x; asm volatile("" : "+v"(tid_)); const int tid = tid_, wid = tid >> 6, lane = tid & 63, wr = wid >> 2, wc = wid & 3, fr = lane & 15, fq = lane >> 4;
  const int b = pm >> 5, blk = pm & 31, t0 = blk * 256, T0 = pm * 256;
  const float* rstd1 = (const float*)(ws + OFF_RSTD1);
  float rsr[2][4];
  if (REG != 1) {
#pragma unroll
    for (int ai = 0; ai < 2; ++ai)
#pragma unroll
      for (int m = 0; m < 4; ++m) rsr[ai][m] = 0.f;
    const f32x4 q0 = *(const f32x4*)((const float*)(ws + OFF_RSTD1Q) + T0 + (wr * 16 + fr) * 8), q1 = *(const f32x4*)((const float*)(ws + OFF_RSTD1Q) + T0 + (wr * 16 + fr) * 8 + 4);
#pragma unroll
    for (int m = 0; m < 4; ++m) { rsr[0][m] = q0[m]; rsr[1][m] = q1[m]; }
  }
  if (REG == 0) {
    const bool isk = pn >= 2;
    const float* cosT = (const float*)(ws + OFF_COS); const float* sinT = (const float*)(ws + OFF_SIN);
    bf16_t* dstb = (bf16_t*)(ws + (isk ? OFF_KR : OFF_QR));
    bf16_t* krt = (bf16_t*)(ws + OFF_KRT);
#pragma unroll
    for (int ai = 0; ai < 2; ++ai)
#pragma unroll
      for (int m = 0; m < 4; ++m) { asm volatile("" ::: "memory");
        const int r = 128 * ai + 64 * wr + 16 * m + fr, t = t0 + r;
        const float rs = rsr[ai][m];
        const f32x4 cs = *(const f32x4*)(cosT + t * 64 + 16 * wc + 4 * fq), sn = *(const f32x4*)(sinT + t * 64 + 16 * wc + 4 * fq);
#pragma unroll
        for (int bj = 0; bj < 2; ++bj) {
          const int h = 2 * (pn & 1) + bj;
          const float sc = fast_exp2((isk ? -1.f : 1.f) * (float)(t & 127) * lg2gamma(h)) * rs;
          const f32x4 x1 = acc[ai][bj][m][0] * sc, x2 = acc[ai][bj][m][1] * sc;
          const f32x4 y1 = x1 * cs - x2 * sn, y2 = x2 * cs + x1 * sn;
          const int d = 16 * wc + 4 * fq;
          const int tl2 = t & 127, r32 = tl2 & 31;
          const int frag = isk ? (((tl2 >> 5) * 2 + ((r32 >> 2) & 1)) * 4 + (d >> 5)) : ((tl2 >> 4) * 4 + (d >> 5));
          const int frl = isk ? ((r32 >> 3) * 4 + (r32 & 3)) : (tl2 & 15);
          bf16_t* dst = dstb + ((long)((b * 4 + h) * 64 + (t >> 7))) * 16384 + (frag * 64 + ((d >> 3) & 3) * 16 + frl) * 8 + (d & 7);
          const u32x2 o1 = pk4(y1), o2 = pk4(y2);
          *(u32x2*)dst = o1; *(u32x2*)(dst + 2 * 512) = o2;
          if (isk) {
            LAS unsigned char* tb = shm + 135168 + wid * 1024;
            LAS bf16_t* w1 = (LAS bf16_t*)(tb + (4 * fq) * 32 + fr * 2);
            w1[0] = (bf16_t)(o1.x & 0xffff); w1[16] = (bf16_t)(o1.x >> 16); w1[32] = (bf16_t)(o1.y & 0xffff); w1[48] = (bf16_t)(o1.y >> 16);
            LAS bf16_t* w2 = w1 + 16 * 16;
            w2[0] = (bf16_t)(o2.x & 0xffff); w2[16] = (bf16_t)(o2.x >> 16); w2[32] = (bf16_t)(o2.y & 0xffff); w2[48] = (bf16_t)(o2.y >> 16);
            asm volatile("s_waitcnt lgkmcnt(0)" ::: "memory");
            const int dl = lane >> 1, th = lane & 1;
            const u32x4 kv = *(const LAS u32x4*)(tb + dl * 32 + th * 16);
            asm volatile("" ::: "memory");
            const int dd = dl < 16 ? 16 * wc + dl : 48 + 16 * wc + dl;
            const int tb0 = t0 + 128 * ai + 64 * wr + 16 * m + 8 * th, tl = tb0 & 127;
            *(u32x4*)(krt + ((long)((b * 4 + h) * 64 + (tb0 >> 7))) * 16384 + (((dd >> 4) * 4 + (tl >> 5)) * 64 + ((tl >> 3) & 3) * 16 + (dd & 15)) * 8) = kv;
          }
        }
      }
  } else if (REG == 1) {
    const bool isr = pn < 8;
    f32x4 rs4[2][2];
#pragma unroll
    for (int bj = 0; bj < 2; ++bj)
#pragma unroll
      for (int n = 0; n < 2; ++n) rs4[bj][n] = *(const f32x4*)(rstd1 + T0 + 128 * bj + 32 * wc + 8 * fq + 4 * n);
#pragma unroll
    for (int bj = 0; bj < 2; ++bj) {
      const int cB = 128 * bj + 32 * wc + 8 * fq;
#pragma unroll
      for (int ai = 0; ai < 2; ++ai)
#pragma unroll
        for (int m = 0; m < 4; ++m) { asm volatile("" ::: "memory");
          const int rA = 128 * ai + 64 * wr + 16 * m + fr;
          bf16_t* dst;
          if (isr) { const int tl = cB & 127;
            dst = (bf16_t*)(ws + OFF_VRT) + ((long)((b * 4 + (pn - 4)) * 64 + 2 * blk + (cB >> 7))) * 32768 + (((rA >> 4) * 4 + (tl >> 5)) * 64 + ((tl >> 3) & 3) * 16 + (rA & 15)) * 8; }
          else dst = (bf16_t*)(ws + OFF_MVT) + ((long)(((b * 8 + (pn - 16) * 4 + (rA >> 6)) * 32 + blk) * 64 + (rA & 63))) * 256 + cB;
          const u32x2 h0 = pk4(acc[ai][bj][m][0] * rs4[bj][0]), h1 = pk4(acc[ai][bj][m][1] * rs4[bj][1]);
          *(u32x4*)dst = (u32x4){h0.x, h0.y, h1.x, h1.y};
        }
    }
  } else if (REG == 2) {
    bf16_t* dstb; int cb;
    if (pn < 12) { dstb = (bf16_t*)(ws + OFF_G); cb = (pn - 8) * 256; }
    else if (pn < 22) { dstb = (bf16_t*)(ws + OFF_GA); cb = (pn - 18) * 256; }
    else { dstb = (bf16_t*)(ws + OFF_GB); cb = (pn - 22) * 256; }
    const bool silu = pn < 12;
#pragma unroll
    for (int ai = 0; ai < 2; ++ai)
#pragma unroll
      for (int m = 0; m < 4; ++m) { asm volatile("" ::: "memory");
        const int r = 128 * ai + 64 * wr + 16 * m + fr;
        const float rs = rsr[ai][m];
#pragma unroll
        for (int bj = 0; bj < 2; ++bj) {
          u32x2 h[2];
#pragma unroll
          for (int n = 0; n < 2; ++n) {
            f32x4 v = acc[ai][bj][m][n] * rs, o;
#pragma unroll
            for (int j = 0; j < 4; ++j) { const float sg = sigmoidf_(v[j]); o[j] = silu ? v[j] * sg : sg; }
            h[n] = pk4(o);
          }
          *(u32x4*)(dstb + (long)(T0 + r) * 1024 + cb + 128 * bj + 32 * wc + 8 * fq) = (u32x4){h[0].x, h[0].y, h[1].x, h[1].y};
        }
      }
  } else {
    const bool isk = pn >= 14;
    const float* nw = isk ? p.k_norm_w : p.q_norm_w;
    bf16_t* dstb = (bf16_t*)(ws + (isk ? OFF_MK : OFF_MQ));
    const int hh = (pn & 1) * 4 + wc;
    f32x4 w4[2][2], cs4[2][2];
#pragma unroll
    for (int bj = 0; bj < 2; ++bj)
#pragma unroll
      for (int n = 0; n < 2; ++n) { w4[bj][n] = *(const f32x4*)(nw + 32 * bj + 8 * fq + 4 * n); cs4[bj][n] = (f32x4){0.f, 0.f, 0.f, 0.f}; }
#pragma unroll
    for (int ai = 0; ai < 2; ++ai)
#pragma unroll
      for (int m = 0; m < 4; ++m) { asm volatile("" ::: "memory");
        const int r = 128 * ai + 64 * wr + 16 * m + fr, t = t0 + r;
        const float rs = rsr[ai][m];
        f32x4 v[2][2]; float ss = 0.f;
#pragma unroll
        for (int bj = 0; bj < 2; ++bj)
#pragma unroll
          for (int n = 0; n < 2; ++n) { v[bj][n] = acc[ai][bj][m][n] * rs; ss += v[bj][n][0] * v[bj][n][0] + v[bj][n][1] * v[bj][n][1] + v[bj][n][2] * v[bj][n][2] + v[bj][n][3] * v[bj][n][3]; }
        ss += __shfl_xor(ss, 16); ss += __shfl_xor(ss, 32);
        const float rn = __builtin_amdgcn_rsqf(ss * (1.0f / 64.0f) + 1e-6f) * (isk ? 1.0f : 0.125f * 1.4426950408889634f);
        bf16_t* dst = dstb + ((long)((b * 8 + hh) * SEQ + t)) * 64 + 8 * fq;
#pragma unroll
        for (int bj = 0; bj < 2; ++bj) {
          const f32x4 o0 = v[bj][0] * rn * w4[bj][0], o1 = v[bj][1] * rn * w4[bj][1]; cs4[bj][0] += o0; cs4[bj][1] += o1;
          const u32x2 h0 = pk4(o0), h1 = pk4(o1);
          *(u32x4*)(dst + 32 * bj) = (u32x4){h0.x, h0.y, h1.x, h1.y};
        }
      }
    if (isk) {
      LAS float* red = (LAS float*)(shm + 131072);
#pragma unroll
      for (int bj = 0; bj < 2; ++bj)
#pragma unroll
        for (int n = 0; n < 2; ++n)
#pragma unroll
          for (int j = 0; j < 4; ++j) {
            float s = cs4[bj][n][j];
            s += __shfl_xor(s, 1); s += __shfl_xor(s, 2); s += __shfl_xor(s, 4); s += __shfl_xor(s, 8);
            if (fr == 0) red[wr * 256 + wc * 64 + 32 * bj + 8 * fq + 4 * n + j] = s;
          }
      __syncthreads();
      if (tid < 256) {
        float* kbar = (float*)(ws + OFF_KBAR);
        kbar[((long)((b * 8 + (pn & 1) * 4 + (tid >> 6)) * 32 + blk)) * 64 + (tid & 63)] = (red[tid] + red[256 + tid]) * (1.0f / 256.0f);
      }
      __syncthreads();
    }
  }
}

template <int REG>
struct SeqInproj {
  const Params& p; const bf16_t* xb; const bf16_t* W; LAS unsigned char* shm;
  static constexpr int NN = REG == 0 ? 4 : (REG == 1 ? 6 : (REG == 2 ? 12 : 4));
  DI bool get(int i, GUnit& u) const {
    int pm, ix;
    if (!tile_map(i, 128, NN, pm, ix)) return false;
    const int pn = REG == 0 ? ix : (REG == 1 ? (ix < 4 ? 4 + ix : 12 + ix) : (REG == 2 ? (ix < 4 ? 8 + ix : 14 + ix) : 12 + ix));
    const bf16_t* a = xb + (long)pm * 256 * DM; const bf16_t* b = W + (long)pn * 256 * DM;
    u.Ap = REG == 1 ? b : a; u.Bp = REG == 1 ? a : b; u.lda = DM; u.ldb = DM; u.ksa = 64; u.ksb = 64; u.nt = 16; u.pm = pm; u.pn = pn; u.permB = REG == 1;
    return true;
  }
  DI void epi(f32x4 (&acc)[2][2][4][2], const GUnit& u) const { epi_inproj<REG>(p, acc, u.pm, u.pn, shm); }
};
template <int REG>
DI void phase1_region(const Params& p, LAS unsigned char* shm) {
  const SeqInproj<REG> seq{p, (const bf16_t*)((unsigned char*)p.out + 64 * MiB), (const bf16_t*)(p.ws + OFF_WIN), shm};
  gemm_stream(seq, shm);
}
DI void phase1(const Params& p, LAS unsigned char* shm) {
  const bf16_t* xb = (const bf16_t*)((unsigned char*)p.out + 64 * MiB); const bf16_t* W = (const bf16_t*)(p.ws + OFF_WIN);
  bool pre = false;
  { const SeqInproj<2> s{p, xb, W, shm}; const SeqInproj<1> sn{p, xb, W, shm}; GUnit t, t0; const bool h = s.get(0, t0), hn = sn.get(0, t); gemm_stream(s, shm, pre, h && hn, t); pre = h && hn; }
  { const SeqInproj<1> s{p, xb, W, shm}; const SeqInproj<0> sn{p, xb, W, shm}; GUnit t, t0; const bool h = s.get(0, t0), hn = sn.get(0, t); gemm_stream(s, shm, pre, h && hn, t); pre = h && hn; }
  { const SeqInproj<0> s{p, xb, W, shm}; const SeqInproj<3> sn{p, xb, W, shm}; GUnit t, t0; const bool h = s.get(0, t0), hn = sn.get(0, t); gemm_stream(s, shm, pre, h && hn, t); pre = h && hn; }
  { const SeqInproj<3> s{p, xb, W, shm}; gemm_stream(s, shm, pre); }
}

DI void ret_scan(const Params& p, LAS unsigned char* shm) {
  unsigned char* ws = p.ws;
  int tid_ = threadIdx.x; asm volatile("" : "+v"(tid_)); const int tid = tid_, wid = tid >> 6, lane = tid & 63, fr = lane & 15, fq = lane >> 4;
  const bf16_t* Vrt = (const bf16_t*)(ws + OFF_VRT); const bf16_t* Krt = (const bf16_t*)(ws + OFF_KRT);
  bf16_t* RT = (bf16_t*)p.out;
  LAS bf16_t* stg = (LAS bf16_t*)shm;
  for (int u0 = blockIdx.x; u0 < 256; u0 += gridDim.x) {
    int u = u0;
    if (gridDim.x == 256) { const int x = u0 & 7, m = u0 >> 3; u = (2 * x + (m >> 4)) * 16 + (m & 15); }
    const int bh = u >> 4, e0 = (u & 15) * 16, h = bh & 3;
    const float lg = lg2gamma(h), g128 = exp2f(128.f * lg), g127 = exp2f(127.f * lg);
    const bf16_t* vp = Vrt + (long)(bh * 64) * 32768 + (e0 >> 4) * 2048 + lane * 8;
    const bf16_t* kp = Krt + (long)(bh * 64) * 16384 + wid * 2048 + lane * 8;
    f32x4 st = {0.f, 0.f, 0.f, 0.f};
    bf16x8 vb[4][4], kb[4][4];
#pragma unroll
    for (int r = 0; r < 4; ++r)
#pragma unroll
      for (int ks = 0; ks < 4; ++ks) { vb[r][ks] = *(const bf16x8*)(vp + r * 32768 + ks * 512); kb[r][ks] = *(const bf16x8*)(kp + r * 16384 + ks * 512); }
#pragma unroll 1
    for (int c0 = 0; c0 < 64; c0 += 8) {
#pragma unroll
      for (int s = 0; s < 8; ++s) {
        const int r = s & 3, c = c0 + s;
        LAS bf16_t* sp = stg + (s * 16 + 4 * fq) * 136 + 16 * wid + fr;
        sp[0] = f2bf(st[0]); sp[136] = f2bf(st[1]); sp[272] = f2bf(st[2]); sp[408] = f2bf(st[3]);
        f32x4 uacc = {0.f, 0.f, 0.f, 0.f};
#pragma unroll
        for (int ks = 0; ks < 4; ++ks) uacc = MFMA16(vb[r][ks], kb[r][ks], uacc);
        st = st * g128 + uacc * g127;
        const int cn = c + 4 < 64 ? c + 4 : 63;
#pragma unroll
        for (int ks = 0; ks < 4; ++ks) { vb[r][ks] = *(const bf16x8*)(vp + cn * 32768 + ks * 512); kb[r][ks] = *(const bf16x8*)(kp + cn * 16384 + ks * 512); }
      }
      __syncthreads();
#pragma unroll
      for (int i = 0; i < 4; ++i) {
        const int pc = tid + i * NTHREADS, s = pc >> 8, ch = (pc >> 4) & 15, el = pc & 15;
        const u32x4 v = *(const LAS u32x4*)(stg + (s * 16 + el) * 136 + ch * 8);
        *(u32x4*)(RT + (long)(bh * 64 + c0 + s) * 32768 + ((((e0 >> 4) * 4 + (ch >> 2)) * 64 + (ch & 3) * 16 + el) * 8)) = v;
      }
      __syncthreads();
    }
  }
}

constexpr int MO_QS = 144;
constexpr int MO_OACC = 0, MO_L = 256 * 64 * 4, MO_CNT = MO_L + 1024, MO_LIST = MO_CNT + 128, MO_Q = MO_LIST + 32 * 256, MO_P = MO_Q + 256 * MO_QS, MO_KBAR = MO_P, MO_END = MO_P + 32768;
static_assert(MO_END <= LDS_BYTES, "moba lds");
DI int mo_oidx(int q, int d4) { return q * 64 + ((d4 ^ (q & 15)) << 2); }

DI void moba_loadkv(const bf16_t* Mk, const bf16_t* Mvt, long krow0, long vrow, int j, int w, int fr, int fq, bf16x8 (&kf)[2][2], bf16x8 (&vf)[8]) {
  const int prow = (fr >> 2) * 8 + (fr & 3);
  const bf16_t* kp = Mk + (krow0 + j * 256 + 32 * w + prow) * 64 + fq * 8;
  kf[0][0] = *(const bf16x8*)kp; kf[0][1] = *(const bf16x8*)(kp + 32); kf[1][0] = *(const bf16x8*)(kp + 256); kf[1][1] = *(const bf16x8*)(kp + 288);
  const bf16_t* vp = Mvt + vrow + ((long)j * 64 + (w & 3) * 16 + fr) * 256 + fq * 8;
#pragma unroll
  for (int ks = 0; ks < 8; ++ks) vf[ks] = *(const bf16x8*)(vp + ks * 32);
}

DI void moba_phase(const Params& p, LAS unsigned char* shm, int mode = 0) {
  const bool dry = mode != 0;
  unsigned char* ws = p.ws;
  int tid_ = threadIdx.x; asm volatile("" : "+v"(tid_)); const int tid = tid_, wid = __builtin_amdgcn_readfirstlane(tid >> 6), lane = tid & 63, fr = lane & 15, fq = lane >> 4;
  const bf16_t* Mk = (const bf16_t*)(ws + OFF_MK); const bf16_t* Mvt = (const bf16_t*)(ws + OFF_MVT);
  bf16_t* Mq = (bf16_t*)(ws + OFF_MQ);
  const float* kbarg = (const float*)(ws + OFF_KBAR);
  const float mb = ((const float*)(ws + OFF_SC))[0];
  const float c2 = mb * 1.4426950408889634f;
  LAS float* oacc = (LAS float*)(shm + MO_OACC); LAS float* lsl = (LAS float*)(shm + MO_L); LAS float* kb = (LAS float*)(shm + MO_KBAR);
  LAS int* cnt = (LAS int*)(shm + MO_CNT); LAS unsigned char* list = shm + MO_LIST; LAS unsigned char* Qs = shm + MO_Q; LAS unsigned char* Pb = shm + MO_P;
  const int dtw = wid & 3, ttw = wid >> 2;
  for (int u = blockIdx.x, it = 0; u < 1024; u += gridDim.x, ++it) {
    int blk = 31 - (u >> 5), bh = u & 31;
    if (gridDim.x == 256) {
      const int x = blockIdx.x & 7, m = blockIdx.x >> 3, m2 = (m + 16) & 31;
      bh = x + 8 * it; blk = it == 0 ? 31 - m : (it == 1 ? m : (it == 2 ? m2 : 31 - m2));
    }
    const long qbase = ((long)bh * SEQ + blk * 256) * 64;
    for (int i = tid; i < 256 * 64; i += NTHREADS) oacc[i] = 0.f;
    if (tid < 256) lsl[tid] = 0.f;
    if (tid < 32) cnt[tid] = 0;
    for (int i = tid; i < blk * 64; i += NTHREADS) kb[i] = kbarg[((long)bh * 32) * 64 + i];
    const int qt = tid >> 1, qh = tid & 1;
    u32x4 qw[4];
    {
      const u32x4* qp = (const u32x4*)(Mq + qbase + (long)qt * 64 + qh * 32);
#pragma unroll
      for (int i = 0; i < 4; ++i) { qw[i] = qp[i]; *(LAS u32x4*)(Qs + qt * MO_QS + qh * 64 + i * 16) = qw[i]; }
    }
    __syncthreads();
    if (blk > 0) {
      float q[32];
#pragma unroll
      for (int i = 0; i < 4; ++i) { const u32x4 w4 = qw[i]; q[8 * i] = __uint_as_float(w4.x << 16); q[8 * i + 1] = __uint_as_float(w4.x & 0xffff0000u); q[8 * i + 2] = __uint_as_float(w4.y << 16); q[8 * i + 3] = __uint_as_float(w4.y & 0xffff0000u);
        q[8 * i + 4] = __uint_as_float(w4.z << 16); q[8 * i + 5] = __uint_as_float(w4.z & 0xffff0000u); q[8 * i + 6] = __uint_as_float(w4.w << 16); q[8 * i + 7] = __uint_as_float(w4.w & 0xffff0000u); }
      float v0 = -3e38f, v1 = -3e38f, v2 = -3e38f; int i0 = -1, i1 = -1, i2 = -1;
      for (int j = 0; j < blk; ++j) {
        float g0 = 0.f, g1 = 0.f;
#pragma unroll
        for (int d = 0; d < 32; d += 8) { const f32x4 k4 = *(const LAS f32x4*)(kb + j * 64 + qh * 32 + d), k5 = *(const LAS f32x4*)(kb + j * 64 + qh * 32 + d + 4);
          g0 += q[d] * k4[0] + q[d + 1] * k4[1] + q[d + 2] * k4[2] + q[d + 3] * k4[3]; g1 += q[d + 4] * k5[0] + q[d + 5] * k5[1] + q[d + 6] * k5[2] + q[d + 7] * k5[3]; }
        float g = g0 + g1;
        g += __shfl_xor(g, 1);
        if (g > v0) { v2 = v1; i2 = i1; v1 = v0; i1 = i0; v0 = g; i0 = j; }
        else if (g > v1) { v2 = v1; i2 = i1; v1 = g; i1 = j; }
        else if (g > v2) { v2 = g; i2 = j; }
      }
      if (qh == 0) {
        if (i0 >= 0) { const int pz = atomicAdd((int*)(cnt + i0), 1); list[i0 * 256 + pz] = (unsigned char)qt; }
        if (i1 >= 0) { const int pz = atomicAdd((int*)(cnt + i1), 1); list[i1 * 256 + pz] = (unsigned char)qt; }
        if (i2 >= 0) { const int pz = atomicAdd((int*)(cnt + i2), 1); list[i2 * 256 + pz] = (unsigned char)qt; }
      }
    }
    __syncthreads();
    const long krow0 = (long)bh * SEQ, vrow = (long)bh * 64 * SEQ;
#define MO_BARRIER do { asm volatile("s_waitcnt lgkmcnt(0)" ::: "memory"); __builtin_amdgcn_s_barrier(); asm volatile("" ::: "memory"); } while (0)
    if (mode != 2) {
      if (wid >= 4) {
        const int sw = wid & 3, prow = (fr >> 2) * 8 + (fr & 3);
        bf16x8 kf[4][2], kn[4][2];
#pragma unroll
        for (int a = 0; a < 4; ++a) { kf[a][0] = (bf16x8){0, 0, 0, 0, 0, 0, 0, 0}; kf[a][1] = kf[a][0]; }
        int stepc = 0;
        auto ssteps = [&](const int j, auto ownc) {
          constexpr bool own = decltype(ownc)::value;
          const int n = j < 0 ? 0 : (own ? 256 : cnt[j]), ntile = (n + 15) >> 4;
          for (int s0 = 0; s0 < ntile; s0 += 2, ++stepc) {
            LAS unsigned char* pbuf = Pb + (stepc & 1) * 16384;
            if (!(mode & 4))
#pragma unroll
            for (int tt = 0; tt < 2; ++tt) {
              const int tile = s0 + tt;
              if (tile < ntile) {
                const int rem = n - tile * 16;
                const int qidx = own ? tile * 16 + fr : (int)list[j * 256 + tile * 16 + (fr < rem ? fr : 0)];
                const bf16x8 q0 = *(const LAS bf16x8*)(Qs + qidx * MO_QS + fq * 16), q1 = *(const LAS bf16x8*)(Qs + qidx * MO_QS + 64 + fq * 16);
#pragma unroll
                for (int g = 0; g < 2; ++g) {
                  f32x4 sv[2];
#pragma unroll
                  for (int par = 0; par < 2; ++par) { sv[par] = MFMA16(kf[g * 2 + par][0], q0, ((f32x4){0.f, 0.f, 0.f, 0.f})); sv[par] = MFMA16(kf[g * 2 + par][1], q1, sv[par]); }
                  float pv[2][4];
#pragma unroll
                  for (int par = 0; par < 2; ++par)
#pragma unroll
                    for (int i = 0; i < 4; ++i) {
                      float pe = fast_exp2(sv[par][i] - c2);
                      if (own) { const int key = 64 * sw + 32 * g + fq * 8 + 4 * par + i; if (key > qidx) pe = 0.f; }
                      pv[par][i] = pe;
                    }
                  u32x4 pw; pw.x = pk2(pv[0][0], pv[0][1]); pw.y = pk2(pv[0][2], pv[0][3]); pw.z = pk2(pv[1][0], pv[1][1]); pw.w = pk2(pv[1][2], pv[1][3]);
                  *(LAS u32x4*)(pbuf + tt * 8192 + (2 * sw + g) * 1024 + lane * 16) = pw;
                }
              }
            }
            MO_BARRIER;
          }
        };
        for (int j = -1; j < blk; ++j) {
          {
            const bf16_t* kp = Mk + (krow0 + (j + 1) * 256 + 64 * sw + prow) * 64 + fq * 8;
#pragma unroll
            for (int g = 0; g < 2; ++g)
#pragma unroll
              for (int par = 0; par < 2; ++par) { kn[g * 2 + par][0] = *(const bf16x8*)(kp + (32 * g + 4 * par) * 64); kn[g * 2 + par][1] = *(const bf16x8*)(kp + (32 * g + 4 * par) * 64 + 32); }
          }
          ssteps(j, std::false_type{});
#pragma unroll
          for (int a = 0; a < 4; ++a) { kf[a][0] = kn[a][0]; kf[a][1] = kn[a][1]; }
        }
        ssteps(blk, std::true_type{});
        MO_BARRIER;
      } else {
        const int ptt = wid >> 1, dh = wid & 1;
        bf16x8 vf[2][8], vn[2][8];
#pragma unroll
        for (int a = 0; a < 2; ++a)
#pragma unroll
          for (int ks = 0; ks < 8; ++ks) vf[a][ks] = (bf16x8){0, 0, 0, 0, 0, 0, 0, 0};
        int stepc = 0;
        auto psteps = [&](const int j, auto ownc) {
          constexpr bool own = decltype(ownc)::value;
          const int n = j < 0 ? 0 : (own ? 256 : cnt[j]), ntile = (n + 15) >> 4;
          for (int s0 = 0; s0 < ntile; s0 += 2, ++stepc) {
            const LAS unsigned char* pbuf = Pb + (stepc & 1) * 16384;
            const int tile = s0 + ptt;
            if (tile < ntile && !(mode & 8)) {
              const int rem = n - tile * 16;
              const bool qv = fr < rem;
              const int qidx = own ? tile * 16 + fr : (int)list[j * 256 + tile * 16 + (qv ? fr : 0)];
              u32x4 pw[8];
#pragma unroll
              for (int ks = 0; ks < 8; ++ks) pw[ks] = *(const LAS u32x4*)(pbuf + ptt * 8192 + ks * 1024 + lane * 16);
              LAS f32x4* op0 = (LAS f32x4*)(oacc + mo_oidx(qidx, dh * 8 + fq)); LAS f32x4* op1 = (LAS f32x4*)(oacc + mo_oidx(qidx, dh * 8 + 4 + fq));
              const f32x4 a0 = *op0, a1 = *op1; const float al = lsl[qidx];
              __builtin_amdgcn_sched_barrier(0);
              f32x4 o0 = {0.f, 0.f, 0.f, 0.f}, o1 = {0.f, 0.f, 0.f, 0.f}, ol = {0.f, 0.f, 0.f, 0.f};
              const bf16x8 ones = {0x3F80, 0x3F80, 0x3F80, 0x3F80, 0x3F80, 0x3F80, 0x3F80, 0x3F80};
#pragma unroll
              for (int ks = 0; ks < 8; ++ks) {
                const bf16x8 pb = __builtin_bit_cast(bf16x8, pw[ks]);
                o0 = MFMA16(vf[0][ks], pb, o0); o1 = MFMA16(vf[1][ks], pb, o1);
                if (dh == 0) ol = MFMA16(ones, pb, ol);
              }
              if (qv) {
                *op0 = a0 + o0; *op1 = a1 + o1;
                if (dh == 0 && fq == 0) lsl[qidx] = al + ol[0];
              }
            }
            MO_BARRIER;
          }
        };
        bool first = true;
        for (int j = -1; j < blk; ++j) {
          {
            const bf16_t* vp = Mvt + vrow + ((long)(j + 1) * 64 + dh * 32 + fr) * 256 + fq * 8;
#pragma unroll
            for (int a = 0; a < 2; ++a)
#pragma unroll
              for (int ks = 0; ks < 8; ++ks) vn[a][ks] = *(const bf16x8*)(vp + a * 16 * 256 + ks * 32);
          }
          if (first) { MO_BARRIER; first = false; }
          psteps(j, std::false_type{});
#pragma unroll
          for (int a = 0; a < 2; ++a)
#pragma unroll
            for (int ks = 0; ks < 8; ++ks) vf[a][ks] = vn[a][ks];
        }
        if (first) { MO_BARRIER; first = false; }
        psteps(blk, std::true_type{});
      }
    }
    __syncthreads();
    {
      const int t = tid >> 1, hf = tid & 1;
      const float il = 1.0f / lsl[t];
      bf16_t* dst = (dry ? (bf16_t*)((unsigned char*)p.out + 64 * MiB) : Mq) + qbase + (long)t * 64 + hf * 32;
#pragma unroll
      for (int i = 0; i < 4; ++i) {
        const f32x4 a = *(const LAS f32x4*)(oacc + mo_oidx(t, hf * 8 + 2 * i)), c = *(const LAS f32x4*)(oacc + mo_oidx(t, hf * 8 + 2 * i + 1));
        u32x4 w4; w4.x = pk2(a[0] * il, a[1] * il); w4.y = pk2(a[2] * il, a[3] * il); w4.z = pk2(c[0] * il, c[1] * il); w4.w = pk2(c[2] * il, c[3] * il);
        *(u32x4*)(dst + 8 * i) = w4;
      }
    }
    __syncthreads();
  }
}

constexpr int RO_Q = 0, RO_K = 32768, RO_P = 65536  , RO_PART = 98304, RO_STAT = RO_PART + 8192, RO_TB = 0, RO_TBW = 10240;
DI void ret_out_phase(const Params& p, LAS unsigned char* shm, int mode = 0) {
  const bool dry = mode != 0;
  unsigned char* ws = p.ws;
  int tid_ = threadIdx.x; asm volatile("" : "+v"(tid_)); const int tid = tid_, wid = __builtin_amdgcn_readfirstlane(tid >> 6), lane = tid & 63, fr = lane & 15, fq = lane >> 4;
  const bf16_t* Qr = (const bf16_t*)(ws + OFF_QR); const bf16_t* Kr = (const bf16_t*)(ws + OFF_KR); const bf16_t* Vrt = (const bf16_t*)(ws + OFF_VRT);
  const bf16_t* RT = (const bf16_t*)p.out;
  bf16_t* G = (bf16_t*)(ws + OFF_G);
#define RO_BARRIER do { asm volatile("s_waitcnt lgkmcnt(0)" ::: "memory"); __builtin_amdgcn_s_barrier(); asm volatile("" ::: "memory"); } while (0)
  for (int u = blockIdx.x; u < 1024; u += gridDim.x) {
    const int bh = u >> 6, c = u & 63, h = bh & 3, b = bh >> 2;
    const float gam = exp2f(lg2gamma(h));
    {
      const u32x4* qg = (const u32x4*)(Qr + (long)(bh * 64 + c) * 16384); const u32x4* kg = (const u32x4*)(Kr + (long)(bh * 64 + c) * 16384);
      u32x4 qv[4], kv[4];
#pragma unroll
      for (int i = 0; i < 4; ++i) { qv[i] = qg[tid + i * NTHREADS]; kv[i] = kg[tid + i * NTHREADS]; }
#pragma unroll
      for (int i = 0; i < 4; ++i) { *(LAS u32x4*)(shm + RO_Q + (tid + i * NTHREADS) * 16) = qv[i]; *(LAS u32x4*)(shm + RO_K + (tid + i * NTHREADS) * 16) = kv[i]; }
    }
    bf16x8 rf[2][4], vf[2][4];
    {
      const bf16_t* rp = RT + (long)(bh * 64 + c) * 32768 + (2 * wid) * 2048 + lane * 8;
      const bf16_t* vp = Vrt + (long)(bh * 64 + c) * 32768 + (2 * wid) * 2048 + lane * 8;
#pragma unroll
      for (int e2 = 0; e2 < 2; ++e2)
#pragma unroll
        for (int ks = 0; ks < 4; ++ks) { rf[e2][ks] = *(const bf16x8*)(rp + e2 * 2048 + ks * 512); vf[e2][ks] = *(const bf16x8*)(vp + e2 * 2048 + ks * 512); }
    }
    RO_BARRIER;
    {
      const int ns2 = (16 * wid + 15) / 32 + 1, n = 16 * wid + fr;
      bf16x8 qb[4];
#pragma unroll
      for (int ks = 0; ks < 4; ++ks) qb[ks] = *(const LAS bf16x8*)(shm + RO_Q + (wid * 4 + ks) * 1024 + lane * 16);
      for (int s2 = 0; s2 < ns2; ++s2) {
        f32x4 s[2];
#pragma unroll
        for (int par = 0; par < 2; ++par) {
          s[par] = (f32x4){0.f, 0.f, 0.f, 0.f};
#pragma unroll
          for (int ks = 0; ks < 4; ++ks) { const bf16x8 kf = *(const LAS bf16x8*)(shm + RO_K + ((s2 * 2 + par) * 4 + ks) * 1024 + lane * 16); s[par] = MFMA16(kf, qb[ks], s[par]); }
#pragma unroll
          for (int i = 0; i < 4; ++i) { const int key2 = 32 * s2 + fq * 8 + 4 * par + i; if (key2 > n) s[par][i] = 0.f; }
        }
        u32x4 pw; pw.x = pk2(s[0][0], s[0][1]); pw.y = pk2(s[0][2], s[0][3]); pw.z = pk2(s[1][0], s[1][1]); pw.w = pk2(s[1][2], s[1][3]);
        *(LAS u32x4*)(shm + RO_P + (wid * 4 + s2) * 1024 + lane * 16) = pw;
      }
    }
    RO_BARRIER;
    f32x4 o[2][8];
#pragma unroll
    for (int e2 = 0; e2 < 2; ++e2)
#pragma unroll
      for (int nt = 0; nt < 8; ++nt) o[e2][nt] = (f32x4){0.f, 0.f, 0.f, 0.f};
#pragma unroll
    for (int nt = 0; nt < 8; ++nt) {
#pragma unroll
      for (int ks = 0; ks < 4; ++ks) {
        const bf16x8 qB = *(const LAS bf16x8*)(shm + RO_Q + (nt * 4 + ks) * 1024 + lane * 16);
        o[0][nt] = MFMA16(rf[0][ks], qB, o[0][nt]); o[1][nt] = MFMA16(rf[1][ks], qB, o[1][nt]);
      }
    }
#pragma unroll
    for (int nt = 0; nt < 8; ++nt) {
      o[0][nt] = o[0][nt] * gam; o[1][nt] = o[1][nt] * gam;
#pragma unroll
      for (int s2 = 0; s2 < (16 * nt + 15) / 32 + 1; ++s2) {
        const bf16x8 pB = *(const LAS bf16x8*)(shm + RO_P + (nt * 4 + s2) * 1024 + lane * 16);
        o[0][nt] = MFMA16(vf[0][s2], pB, o[0][nt]); o[1][nt] = MFMA16(vf[1][s2], pB, o[1][nt]);
      }
    }
    {
      LAS f32x2* part = (LAS f32x2*)(shm + RO_PART);
#pragma unroll
      for (int nt = 0; nt < 8; ++nt) {
        float s1 = 0.f, s2q = 0.f;
#pragma unroll
        for (int e2 = 0; e2 < 2; ++e2)
#pragma unroll
          for (int i = 0; i < 4; ++i) { const float v = o[e2][nt][i]; s1 += v; s2q += v * v; }
        s1 += __shfl_xor(s1, 16); s1 += __shfl_xor(s1, 32); s2q += __shfl_xor(s2q, 16); s2q += __shfl_xor(s2q, 32);
        if (fq == 0) part[wid * 128 + nt * 16 + fr] = (f32x2){s1, s2q};
      }
    }
    RO_BARRIER;
    if (tid < 128) {
      const LAS f32x2* part = (const LAS f32x2*)(shm + RO_PART);
      float s1 = 0.f, s2q = 0.f;
#pragma unroll
      for (int w = 0; w < 8; ++w) { const f32x2 v = part[w * 128 + tid]; s1 += v.x; s2q += v.y; }
      const float mu = s1 * (1.0f / 256.0f), var = fmaxf(s2q * (1.0f / 256.0f) - mu * mu, 0.f);
      ((LAS f32x2*)(shm + RO_STAT))[tid] = (f32x2){mu, __builtin_amdgcn_rsqf(var + 1e-5f)};
    }
    RO_BARRIER;
    {
      LAS unsigned char* tb = shm + RO_TB + wid * RO_TBW;
#pragma unroll
      for (int nt = 0; nt < 8; ++nt) {
        const f32x2 st = ((const LAS f32x2*)(shm + RO_STAT))[nt * 16 + fr];
#pragma unroll
        for (int e2 = 0; e2 < 2; ++e2) *(LAS u32x2*)(tb + (nt * 16 + fr) * 80 + (e2 * 16 + 4 * fq) * 2) = pk4((o[e2][nt] - st.x) * st.y);
      }
      asm volatile("s_waitcnt lgkmcnt(0)" ::: "memory");
      bf16_t* gbase = G + ((long)b * SEQ + c * 128) * 1024 + h * 256 + 32 * wid;
      bf16_t* obase = dry ? (bf16_t*)((unsigned char*)p.out + 64 * MiB) + (gbase - G) : gbase;
      u32x4 gv[8];
#pragma unroll
      for (int r = 0; r < 8; ++r) { const int idx = r * 64 + lane; gv[r] = *(const u32x4*)(gbase + (long)(idx >> 2) * 1024 + (idx & 3) * 8); }
#pragma unroll
      for (int r = 0; r < 8; ++r) {
        const int idx = r * 64 + lane, nn = idx >> 2, ch = idx & 3;
        const u32x4 ov = *(const LAS u32x4*)(tb + nn * 80 + ch * 16);
        u32x4 w4;
        { const f32x4 a = unpk4((u32x2){ov.x, ov.y}) * unpk4((u32x2){gv[r].x, gv[r].y}), c2 = unpk4((u32x2){ov.z, ov.w}) * unpk4((u32x2){gv[r].z, gv[r].w});
          w4.x = pk2(a[0], a[1]); w4.y = pk2(a[2], a[3]); w4.z = pk2(c2[0], c2[1]); w4.w = pk2(c2[2], c2[3]); }
        *(u32x4*)(obase + (long)nn * 1024 + ch * 8) = w4;
      }
    }
    __syncthreads();
  }
}

struct SeqMerge {
  const Params& p; bf16_t* tmpb; bf16_t* mixb;
  DI bool get(int i, GUnit& u) const {
    int pm, pn;
    if (!tile_map(i >> 1, 128, 4, pm, pn)) return false;
    unsigned char* ws = p.ws;
    if ((i & 1) == 0) { const int b = pm >> 5, t0 = (pm & 31) * 256;
      u.Ap = (const bf16_t*)(ws + OFF_MQ) + ((long)b * 8 * SEQ + t0) * 64; u.lda = 64; u.ksa = (long)SEQ * 64; u.Bp = (const bf16_t*)(ws + OFF_WMO) + (long)pn * 256 * 512; u.ldb = 512; u.ksb = 64; u.nt = 8; }
    else { u.Ap = (const bf16_t*)(ws + OFF_G) + (long)pm * 256 * 1024; u.lda = 1024; u.ksa = 64; u.Bp = (const bf16_t*)(ws + OFF_WRO) + (long)pn * 256 * 1024; u.ldb = 1024; u.ksb = 64; u.nt = 16; }
    u.pm = pm; u.pn = pn | ((i & 1) << 4); u.permB = 0;
    return true;
  }
  DI void epi(f32x4 (&acc)[2][2][4][2], const GUnit& u) const {
    unsigned char* ws = p.ws;
    int tid_ = threadIdx.x; asm volatile("" : "+v"(tid_)); const int tid = tid_, wid = tid >> 6, lane = tid & 63, wr = wid >> 2, wc = wid & 3, fr = lane & 15, fq = lane >> 4;
    const int pn = u.pn & 15; const bool pass2 = (u.pn >> 4) != 0;
    const bf16_t* gate = (const bf16_t*)(ws + (pass2 ? OFF_GA : OFF_GB)); bf16_t* dst = pass2 ? mixb : tmpb;
#pragma unroll
    for (int ai = 0; ai < 2; ++ai)
#pragma unroll
      for (int m = 0; m < 4; ++m) { asm volatile("" ::: "memory");
        const long row = (long)u.pm * 256 + 128 * ai + 64 * wr + 16 * m + fr;
#pragma unroll
        for (int bj = 0; bj < 2; ++bj) {
          const long off = row * 1024 + pn * 256 + 128 * bj + 32 * wc + 8 * fq;
          const u32x4 g4 = *(const u32x4*)(gate + off);
          f32x4 v0 = unpk4((u32x2){g4.x, g4.y}) * acc[ai][bj][m][0], v1 = unpk4((u32x2){g4.z, g4.w}) * acc[ai][bj][m][1];
          if (pass2) { const u32x4 t4 = *(const u32x4*)(tmpb + off); v0 += unpk4((u32x2){t4.x, t4.y}); v1 += unpk4((u32x2){t4.z, t4.w}); }
          const u32x2 h0 = pk4(v0), h1 = pk4(v1);
          *(u32x4*)(dst + off) = (u32x4){h0.x, h0.y, h1.x, h1.y};
        }
      }
  }
};
DI void phase_merge(const Params& p, LAS unsigned char* shm, bool dry = false) {
  const SeqMerge seq{p, dry ? (bf16_t*)p.out : (bf16_t*)(p.ws + OFF_GB), dry ? (bf16_t*)((unsigned char*)p.out + 64 * MiB) : (bf16_t*)(p.ws + OFF_GA)};
  gemm_stream(seq, shm);
}

struct SeqWo {
  const Params& p; LAS unsigned char* shm;
  DI bool get(int i, GUnit& u) const {
    int pm, pn;
    if (!tile_map(i, 128, 4, pm, pn)) return false;
    u.Ap = (const bf16_t*)(p.ws + OFF_GA) + (long)pm * 256 * 1024; u.Bp = (const bf16_t*)(p.ws + OFF_WO) + (long)pn * 256 * 1024;
    u.lda = 1024; u.ldb = 1024; u.ksa = 64; u.ksb = 64; u.nt = 16; u.pm = pm; u.pn = pn; u.permB = 0;
    return true;
  }
  DI void epi(f32x4 (&acc)[2][2][4][2], const GUnit& u) const {
    unsigned char* ws = p.ws;
    int tid_ = threadIdx.x; asm volatile("" : "+v"(tid_)); const int tid = tid_, wid = tid >> 6, lane = tid & 63, wr = wid >> 2, wc = wid & 3, fr = lane & 15, fq = lane >> 4;
    LAS float* red = (LAS float*)(shm + 131072);
    const int pm = u.pm, pn = u.pn;
#pragma unroll
    for (int ai = 0; ai < 2; ++ai) {
      f32x4 pre[4][2][2];
#pragma unroll
      for (int m = 0; m < 4; ++m)
#pragma unroll
        for (int bj = 0; bj < 2; ++bj) { const long off = ((long)pm * 256 + 128 * ai + 64 * wr + 16 * m + fr) * 1024 + pn * 256 + 128 * bj + 32 * wc + 8 * fq;
          pre[m][bj][0] = *(const f32x4*)(p.x + off); pre[m][bj][1] = *(const f32x4*)(p.x + off + 4); }
      asm volatile("" ::: "memory");
#pragma unroll
      for (int m = 0; m < 4; ++m) {
        const int rl = 128 * ai + 64 * wr + 16 * m + fr;
        const long row = (long)pm * 256 + rl;
        float ss = 0.f;
#pragma unroll
        for (int bj = 0; bj < 2; ++bj) {
          const long off = row * 1024 + pn * 256 + 128 * bj + 32 * wc + 8 * fq;
          const f32x4 v0 = pre[m][bj][0] + acc[ai][bj][m][0], v1 = pre[m][bj][1] + acc[ai][bj][m][1];
          *(f32x4*)(p.out + off) = v0; *(f32x4*)(p.out + off + 4) = v1;
          const u32x2 h0 = pk4(v0), h1 = pk4(v1);
          *(u32x4*)((bf16_t*)(ws + OFF_X1B) + off) = (u32x4){h0.x, h0.y, h1.x, h1.y};
          ss += ((v0[0] * v0[0] + v0[1] * v0[1]) + (v0[2] * v0[2] + v0[3] * v0[3])) + ((v1[0] * v1[0] + v1[1] * v1[1]) + (v1[2] * v1[2] + v1[3] * v1[3]));
        }
        ss += __shfl_xor(ss, 16); ss += __shfl_xor(ss, 32);
        if (fq == 0) red[wc * 256 + rl] = ss;
      }
      asm volatile("" ::: "memory");
    }
    __syncthreads();
    if (tid < 256) ((float*)(ws + OFF_SSQ))[((long)pm * 256 + tid) * 4 + pn] = (red[tid] + red[256 + tid]) + (red[512 + tid] + red[768 + tid]);
    __syncthreads();
  }
};
DI void phase_wo(const Params& p, LAS unsigned char* shm) {
  const SeqWo seq{p, shm};
  gemm_stream(seq, shm);
}

DI void epi_gu(const Params& p, f32x4 (&acc)[2][2][4][2], int pm, int pn, int emode = 0) {
  unsigned char* ws = p.ws;
  int tid_ = threadIdx.x; asm volatile("" : "+v"(tid_)); const int tid = tid_, wid = tid >> 6, lane = tid & 63, wr = wid >> 2, wc = wid & 3, fr = lane & 15, fq = lane >> 4;
  const float* ssq = (const float*)(ws + OFF_SSQ);
  float rsr[2][4];
#pragma unroll
  for (int ai = 0; ai < 2; ++ai)
#pragma unroll
    for (int m = 0; m < 4; ++m) { const long row = (long)pm * 256 + 128 * ai + 64 * wr + 16 * m + fr;
      const f32x4 s4 = *(const f32x4*)(ssq + row * 4);
      rsr[ai][m] = __builtin_amdgcn_rsqf(((s4[0] + s4[1]) + (s4[2] + s4[3])) * (1.0f / DM) + 1e-6f); }
#pragma unroll
  for (int ai = 0; ai < 2; ++ai)
#pragma unroll
    for (int m = 0; m < 4; ++m) { asm volatile("" ::: "memory");
      const long row = (long)pm * 256 + 128 * ai + 64 * wr + 16 * m + fr;
      const float rs = rsr[ai][m];
      {
        u32x2 h[2];
#pragma unroll
        for (int n = 0; n < 2; ++n) {
          const f32x4 g = acc[ai][0][m][n] * rs, uu = acc[ai][1][m][n] * rs; f32x4 o;
#pragma unroll
          for (int j = 0; j < 4; ++j) o[j] = g[j] * sigmoidf_(g[j]) * uu[j];
          h[n] = pk4(o);
        }
        *(u32x4*)((bf16_t*)(ws + OFF_HID) + row * FH + pn * 128 + 32 * wc + 8 * fq) = (u32x4){h[0].x, h[0].y, h[1].x, h[1].y};
      }
    }
}
struct SeqGu {
  const Params& p; int emode;
  DI bool get(int i, GUnit& u) const {
    int pm, pn;
    if (!tile_map(i, 128, 22, pm, pn)) return false;
    u.Ap = (const bf16_t*)(p.ws + OFF_X1B) + (long)pm * 256 * 1024; u.Bp = (const bf16_t*)(p.ws + OFF_WGU) + (long)pn * 256 * 1024;
    u.lda = 1024; u.ldb = 1024; u.ksa = 64; u.ksb = 64; u.nt = 16; u.pm = pm; u.pn = pn; u.permB = 0;
    return true;
  }
  DI void epi(f32x4 (&acc)[2][2][4][2], const GUnit& u) const { if (emode != 2 || p.x == nullptr) epi_gu(p, acc, u.pm, u.pn, emode); }
};
DI void phase_gu(const Params& p, LAS unsigned char* shm, int emode = 0) {
  const SeqGu seq{p, emode};
  gemm_stream(seq, shm);
}

struct SeqDown {
  const Params& p; float* outw;
  DI bool get(int i, GUnit& u) const {
    int pm, pn;
    if (!tile_map(i, 128, 4, pm, pn)) return false;
    u.Ap = (const bf16_t*)(p.ws + OFF_HID) + (long)pm * 256 * FH; u.Bp = (const bf16_t*)(p.ws + OFF_WD) + (long)pn * 256 * FH;
    u.lda = FH; u.ldb = FH; u.ksa = 64; u.ksb = 64; u.nt = FH / 64; u.pm = pm; u.pn = pn; u.permB = 0;
    return true;
  }
  DI void epi(f32x4 (&acc)[2][2][4][2], const GUnit& u) const {
    int tid_ = threadIdx.x; asm volatile("" : "+v"(tid_)); const int tid = tid_, wid = tid >> 6, lane = tid & 63, wr = wid >> 2, wc = wid & 3, fr = lane & 15, fq = lane >> 4;
    const long cbase = ((long)u.pm * 256 + 64 * wr + fr) * 1024 + u.pn * 256 + 32 * wc + 4 * fq;
#pragma unroll
    for (int ai = 0; ai < 2; ++ai) {
      f32x4 pre[4][2][2];
#pragma unroll
      for (int m = 0; m < 4; ++m)
#pragma unroll
        for (int bj = 0; bj < 2; ++bj)
#pragma unroll
          for (int n = 0; n < 2; ++n) pre[m][bj][n] = *(const f32x4*)(p.out + cbase + (long)(128 * ai + 16 * m) * 1024 + 128 * bj + 16 * n);
      asm volatile("" ::: "memory");
#pragma unroll
      for (int m = 0; m < 4; ++m)
#pragma unroll
        for (int bj = 0; bj < 2; ++bj)
#pragma unroll
          for (int n = 0; n < 2; ++n) *(f32x4*)(outw + cbase + (long)(128 * ai + 16 * m) * 1024 + 128 * bj + 16 * n) = pre[m][bj][n] + acc[ai][bj][m][n];
      asm volatile("" ::: "memory");
    }
  }
};
DI void phase_down(const Params& p, LAS unsigned char* shm, bool dry = false) {
  const SeqDown seq{p, dry ? (float*)(p.ws + OFF_MK) : p.out};
  gemm_stream(seq, shm);
}

#define XB_TMO      128
#define XB_XCNT(j)  (256  + 64 * (j))
#define XB_XSUB(j)  (1280 + 64 * (j))
#define XB_XGEN(j)  (2304 + 64 * (j))
#define XB_TOP      3328
#define XB_TOPGEN   3392
#define XCD_BAR_WORDS 3456
#define XB_SPIN_CAP (1u << 18)
DI unsigned xb_ld(unsigned* p) { return __hip_atomic_load(p, __ATOMIC_RELAXED, __HIP_MEMORY_SCOPE_AGENT); }
DI unsigned xb_add(unsigned* p, unsigned v) { return __hip_atomic_fetch_add(p, v, __ATOMIC_RELAXED, __HIP_MEMORY_SCOPE_AGENT); }
DI unsigned xb_xcc_id() { return (unsigned)__builtin_amdgcn_s_getreg((3 << 11) | 20) & 0xFu; }
#define XB_SPIN(cond, bar) do { unsigned _sp = 0; while (cond) { __builtin_amdgcn_s_sleep(1); \
    if ((++_sp & 255u) == 0u) { if (xb_ld(&(bar)[XB_TMO])) break; if (_sp > XB_SPIN_CAP) { atomicAdd(&(bar)[XB_TMO], 1u); break; } } } } while (0)
struct XcdBarrier { unsigned* bar; unsigned x; volatile LAS unsigned* st; };
DI XcdBarrier xcd_barrier_post(unsigned* bar, volatile LAS unsigned* st) {
  XcdBarrier b; b.bar = bar; b.x = xb_xcc_id(); b.st = st;
  if (threadIdx.x == 0) (void)xb_add(&bar[XB_XCNT(b.x)], 1u);
  return b;
}
DI void xcd_barrier_complete(unsigned* bar, unsigned x, unsigned& nloc, unsigned& nx) {
  const unsigned G = gridDim.x * gridDim.y * gridDim.z;
  unsigned sum, cnt, mine, sp = 0u;
  for (;;) {
    sum = 0u; cnt = 0u; mine = 0u;
#pragma unroll
    for (unsigned j = 0; j < 16; ++j) { const unsigned c = xb_ld(&bar[XB_XCNT(j)]); sum += c; cnt += (c > 0u) ? 1u : 0u; mine = (j == x) ? c : mine; }
    if (sum == G) break;
    __builtin_amdgcn_s_sleep(1);
    if ((++sp & 255u) == 0u) { if (xb_ld(&bar[XB_TMO])) break; if (sp > XB_SPIN_CAP) { atomicAdd(&bar[XB_TMO], 1u); break; } }
  }
  nloc = mine > 0u ? mine : 1u; nx = cnt > 0u ? cnt : 1u;
}
DI void xcd_barrier(const XcdBarrier& b) {
  asm volatile("s_waitcnt vmcnt(0)" ::: "memory");
  __syncthreads();
  if (threadIdx.x == 0) {
    unsigned* bar = b.bar;
    __builtin_amdgcn_s_waitcnt(0);
    unsigned nloc = b.st[0], nx = b.st[1];
    if (nloc == 0u) { xcd_barrier_complete(bar, b.x, nloc, nx); b.st[0] = nloc; b.st[1] = nx; }
    const unsigned old = xb_add(&bar[XB_XSUB(b.x)], 1u);
    const unsigned gen = old / nloc;
    if (old + 1u == (gen + 1u) * nloc) {
      __builtin_amdgcn_fence(__ATOMIC_RELEASE, "agent");
      asm volatile("s_waitcnt vmcnt(0)" ::: "memory");
      const unsigned og = xb_add(&bar[XB_TOP], 1u);
      const unsigned tg = og / nx;
      if (og + 1u == (tg + 1u) * nx) xb_add(&bar[XB_TOPGEN], 1u);
      else XB_SPIN(xb_ld(&bar[XB_TOPGEN]) == tg, bar);
      __builtin_amdgcn_fence(__ATOMIC_ACQUIRE, "agent");
      xb_add(&bar[XB_XGEN(b.x)], 1u);
      asm volatile("s_waitcnt vmcnt(0)" ::: "memory");
    } else {
      XB_SPIN(xb_ld(&bar[XB_XGEN(b.x)]) == gen, bar);
      __builtin_amdgcn_fence(__ATOMIC_ACQUIRE, "agent");
      asm volatile("s_waitcnt vmcnt(0)" ::: "memory");
    }
  }
  __syncthreads();
}

__global__ void __launch_bounds__(NTHREADS) fwd_megakernel(Params p) {
  extern __shared__ __attribute__((aligned(16))) unsigned char shm_raw[];
  LAS unsigned char* shm = (LAS unsigned char*)shm_raw;
  cg::grid_group grid = cg::this_grid();
  volatile LAS unsigned* xst = (volatile LAS unsigned*)(shm + LDS_BYTES - 16);
  if (threadIdx.x == 0) { xst[0] = 0u; xst[1] = 0u; }
  unsigned* bar = (unsigned*)(p.ws + OFF_BAR);
  __syncthreads();
  const XcdBarrier xb = xcd_barrier_post(bar, xst);
  phase0(p, shm);
  if (p.x == nullptr) grid.sync();
  xcd_barrier(xb);
  phase1(p, shm);
  xcd_barrier(xb);
  ret_scan(p, shm);
  moba_phase(p, shm);
  xcd_barrier(xb);
  ret_out_phase(p, shm);
  xcd_barrier(xb);
  phase_merge(p, shm);
  xcd_barrier(xb);
  phase_wo(p, shm);
  xcd_barrier(xb);
  phase_gu(p, shm);
  xcd_barrier(xb);
  phase_down(p, shm);
}

extern "C" void kernel_launch(void* const* d_in, const int* in_sizes, int n_in, void* d_out, int out_size, void* d_ws, size_t ws_size, hipStream_t stream) {
  static int grid_blocks = 0;
  if (grid_blocks == 0) {
    if (n_in != 12 || out_size != T_TOK * DM || ws_size < WS_END) { fprintf(stderr, "kernel_launch: unexpected shapes / workspace (n_in %d out %d ws %zu need %zu)\n", n_in, out_size, ws_size, (size_t)WS_END); grid_blocks = -1; return; }
    int dev = 0, cus = 0, per_cu = 0;
    hipGetDevice(&dev);
    hipDeviceGetAttribute(&cus, hipDeviceAttributeMultiprocessorCount, dev);
    if (hipFuncSetAttribute((const void*)fwd_megakernel, hipFuncAttributeMaxDynamicSharedMemorySize, LDS_BYTES) != hipSuccess) { fprintf(stderr, "hipFuncSetAttribute failed\n"); grid_blocks = -1; return; }
    hipOccupancyMaxActiveBlocksPerMultiprocessor(&per_cu, (const void*)fwd_megakernel, NTHREADS, LDS_BYTES);
    if (per_cu < 1) { fprintf(stderr, "occupancy query says %d blocks/CU\n", per_cu); per_cu = 1; }
    if (per_cu > 1) per_cu = 1;
    grid_blocks = cus * per_cu;
  }
  if (grid_blocks < 0) return;
  Params p{};
  p.x = (const float*)d_in[0]; p.norm1_w = (const float*)d_in[1]; p.w_in = (const float*)d_in[2]; p.q_norm_w = (const float*)d_in[3]; p.k_norm_w = (const float*)d_in[4];
  p.w_ret_out = (const float*)d_in[5]; p.w_moba_out = (const float*)d_in[6]; p.w_o = (const float*)d_in[7]; p.norm2_w = (const float*)d_in[8];
  p.w_gate = (const float*)d_in[9]; p.w_up = (const float*)d_in[10]; p.w_down = (const float*)d_in[11];
  p.out = (float*)d_out; p.ws = (unsigned char*)d_ws;
  void* args[] = {&p};
  if (hipMemsetAsync((unsigned char*)d_ws + OFF_BAR, 0, 16384, stream) != hipSuccess) { fprintf(stderr, "hipMemsetAsync of the barrier words failed\n"); return; }
  hipError_t e = hipLaunchCooperativeKernel((const void*)fwd_megakernel, dim3(grid_blocks), dim3(NTHREADS), args, LDS_BYTES, stream);
  if (e != hipSuccess) fprintf(stderr, "cooperative launch failed: %s (grid %d)\n", hipGetErrorString(e), grid_blocks);
}
```

```cpp
#include <hip/hip_runtime.h>
#include <hip/hip_cooperative_groups.h>
#include <cstdio>
#include <cstdint>
#include <type_traits>
namespace cg = cooperative_groups;

#define DI __device__ __forceinline__
#define LAS __attribute__((address_space(3)))
typedef unsigned short bf16_t;
typedef short bf16x8 __attribute__((ext_vector_type(8)));
typedef float f32x4 __attribute__((ext_vector_type(4)));
typedef float f32x2 __attribute__((ext_vector_type(2)));
typedef __bf16 bf16v2 __attribute__((ext_vector_type(2)));
typedef unsigned u32x2 __attribute__((ext_vector_type(2)));
typedef unsigned u32x4 __attribute__((ext_vector_type(4)));

constexpr int T_TOK = 32768, SEQ = 8192, DM = 1024, NCOL = 6656, FH = 2816;
constexpr int NTHREADS = 512;
constexpr int LDS_BYTES = 147456;
constexpr size_t MiB = 1048576;
constexpr size_t OFF_WIN = 0;
constexpr size_t OFF_WRO = OFF_WIN + 13 * MiB;
constexpr size_t OFF_WMO = OFF_WRO + 2 * MiB;
constexpr size_t OFF_WO  = OFF_WMO + 1 * MiB;
constexpr size_t OFF_WGU = OFF_WO + 2 * MiB;
constexpr size_t OFF_WD  = OFF_WGU + 11 * MiB;
constexpr size_t OFF_QR  = OFF_WD + 6 * MiB;
constexpr size_t OFF_KR  = OFF_QR + 32 * MiB;
constexpr size_t OFF_KRT = OFF_KR + 32 * MiB;
constexpr size_t OFF_VRT = OFF_KRT + 32 * MiB;
constexpr size_t OFF_G   = OFF_VRT + 64 * MiB;
constexpr size_t OFF_MQ  = OFF_G + 64 * MiB;
constexpr size_t OFF_MK  = OFF_MQ + 32 * MiB;
constexpr size_t OFF_MVT = OFF_MK + 32 * MiB;
constexpr size_t OFF_GA  = OFF_MVT + 32 * MiB;
constexpr size_t OFF_GB  = OFF_GA + 64 * MiB;
constexpr size_t OFF_MISC = OFF_GB + 64 * MiB;
constexpr size_t OFF_COS = OFF_MISC;
constexpr size_t OFF_SIN = OFF_COS + 2 * MiB;
constexpr size_t OFF_RSTD1 = OFF_SIN + 2 * MiB;
constexpr size_t OFF_SSQ = OFF_RSTD1 + 131072;
constexpr size_t OFF_KBAR = OFF_SSQ + 4 * 131072;
constexpr size_t OFF_SC = OFF_KBAR + 262144;
constexpr size_t OFF_BAR = OFF_SC + 4096;
constexpr size_t OFF_RSTD1Q = OFF_BAR + 16384;
constexpr size_t WS_END = OFF_RSTD1Q + 131072;
constexpr size_t OFF_X1B = OFF_QR;
constexpr size_t OFF_HID = OFF_KRT;

struct Params {
  const float *x, *norm1_w, *w_in, *q_norm_w, *k_norm_w, *w_ret_out, *w_moba_out, *w_o, *norm2_w, *w_gate, *w_up, *w_down;
  float* out;
  unsigned char* ws;
};

DI unsigned pk2(float lo, float hi) { f32x2 v = {lo, hi}; bf16v2 b = __builtin_convertvector(v, bf16v2); return __builtin_bit_cast(unsigned, b); }
DI bf16_t f2bf(float x) { return (bf16_t)(pk2(x, 0.f) & 0xffffu); }
DI u32x2 pk4(f32x4 v) { u32x2 r; r.x = pk2(v[0], v[1]); r.y = pk2(v[2], v[3]); return r; }
DI float bf2f(bf16_t v) { return __uint_as_float(((unsigned)v) << 16); }
DI f32x4 unpk4(u32x2 u) { f32x4 r; r[0] = __uint_as_float(u.x << 16); r[1] = __uint_as_float(u.x & 0xffff0000u); r[2] = __uint_as_float(u.y << 16); r[3] = __uint_as_float(u.y & 0xffff0000u); return r; }
DI float lg2gamma(int h) { return h == 0 ? -0.045803689613124f : (h == 1 ? -0.022720076500083f : (h == 2 ? -0.011315313227834f : -0.005646563141142f)); }
DI float fast_exp2(float x) { return __builtin_amdgcn_exp2f(x); }
DI float sigmoidf_(float v) { return __builtin_amdgcn_rcpf(1.f + fast_exp2(-1.4426950408889634f * v)); }
#define MFMA16(a, b, c) __builtin_amdgcn_mfma_f32_16x16x32_bf16((a), (b), (c), 0, 0, 0)

DI int lds_byte(int r, int c) { const int st = (r >> 4) * 2 + (c >> 5), rr = r & 15, cc = c & 31, ob = rr * 64 + cc * 2; return st * 1024 + (ob ^ (((ob >> 9) & 1) << 5)); }
DI void stage_rc(int b, int& R, int& C) { const int st = b / 1024, sb = b % 1024, swz = sb ^ (((sb >> 9) & 1) << 5); R = (st >> 1) * 16 + swz / 64; C = (st & 1) * 32 + (swz % 64) / 2; }
DI void glds16(const bf16_t* g, LAS unsigned char* l) {
  __builtin_amdgcn_global_load_lds((const __attribute__((address_space(1))) unsigned*)g, (LAS unsigned*)l, 16, 0, 0);
}

DI void gemm_main(const bf16_t* Ap, long lda, long ksa, const bf16_t* Bp, long ldb, long ksb, int nt, LAS unsigned char* shm, f32x4 (&acc)[2][2][4][2], const bool pre = false) {
  int tid_ = threadIdx.x; asm volatile("" : "+v"(tid_)); const int tid = tid_, wid = __builtin_amdgcn_readfirstlane(tid >> 6), lane = tid & 63, wr = wid >> 2, wc = wid & 3, fr = lane & 15, fq = lane >> 4;
  int voffA[2], voffB[2];
#pragma unroll
  for (int i = 0; i < 2; ++i) { int R, C; stage_rc(tid * 16 + i * 8192, R, C); voffA[i] = R * (int)lda + C; voffB[i] = R * (int)ldb + C; }
  const int aoff = lds_byte(wr * 64 + fr, fq * 8), boff = lds_byte(wc * 32 + fr, fq * 8);
  LAS unsigned char* ldsw = shm + wid * 1024;
  const long hA = 128 * lda, hB = 128 * ldb;
#pragma unroll
  for (int ai = 0; ai < 2; ++ai)
#pragma unroll
    for (int bj = 0; bj < 2; ++bj)
#pragma unroll
      for (int m = 0; m < 4; ++m)
#pragma unroll
        for (int n = 0; n < 2; ++n) acc[ai][bj][m][n] = (f32x4){0.f, 0.f, 0.f, 0.f};
  bf16x8 At[4][2], B0[2][2], B1[2][2];
#define G_SA(b, h) (((b) * 2 + (h)) * 16384)
#define G_SB(b, h) ((4 + (b) * 2 + (h)) * 16384)
#define G_STAGE(bufoff, gp, voff) do { const bf16_t* gp_ = (gp); glds16(gp_ + (voff)[0], ldsw + (bufoff)); glds16(gp_ + (voff)[1], ldsw + (bufoff) + 8192); } while (0)
#define G_A0(kt) (Ap + (long)(kt) * ksa)
#define G_A1(kt) (Ap + hA + (long)(kt) * ksa)
#define G_B0(kt) (Bp + (long)(kt) * ksb)
#define G_B1(kt) (Bp + hB + (long)(kt) * ksb)
#define G_LDA(dst, b, h) do { _Pragma("unroll") for (int m = 0; m < 4; ++m) _Pragma("unroll") for (int k = 0; k < 2; ++k) dst[m][k] = *(const LAS bf16x8*)(shm + G_SA(b, h) + aoff + m * 2048 + k * 1024); } while (0)
#define G_LDB(dst, b, h) do { _Pragma("unroll") for (int n = 0; n < 2; ++n) _Pragma("unroll") for (int k = 0; k < 2; ++k) dst[n][k] = *(const LAS bf16x8*)(shm + G_SB(b, h) + boff + n * 2048 + k * 1024); } while (0)
#define G_MMA(ai, bj, A_, B_) do { __builtin_amdgcn_s_setprio(1); _Pragma("unroll") for (int m = 0; m < 4; ++m) _Pragma("unroll") for (int n = 0; n < 2; ++n) _Pragma("unroll") for (int k = 0; k < 2; ++k) \
    acc[ai][bj][m][n] = MFMA16(B_[n][k], A_[m][k], acc[ai][bj][m][n]); __builtin_amdgcn_s_setprio(0); } while (0)
#define G_WAIT_V(n) asm volatile("s_waitcnt vmcnt(" #n ")" ::: "memory")
#define G_WAIT_L(n) asm volatile("s_waitcnt lgkmcnt(" #n ")" ::: "memory")
#define G_BAR __builtin_amdgcn_s_barrier()
#define G_SCHED __builtin_amdgcn_sched_barrier(0)
  G_WAIT_V(0);
  if (!pre) {
    G_STAGE(G_SB(0, 0), G_B0(0), voffB); G_STAGE(G_SA(0, 0), G_A0(0), voffA); G_STAGE(G_SB(0, 1), G_B1(0), voffB); G_STAGE(G_SA(0, 1), G_A1(0), voffA);
    if (wr == 1) G_BAR;
    G_WAIT_V(4); G_BAR;
    G_STAGE(G_SB(1, 0), G_B0(1), voffB); G_STAGE(G_SA(1, 0), G_A0(1), voffA); G_STAGE(G_SB(1, 1), G_B1(1), voffB);
    G_WAIT_V(6); G_BAR;
  } else {
    if (wr == 1) G_BAR;
    G_BAR; G_BAR;
  }
#pragma unroll 1
  for (int t = 0; t < nt - 2; t += 2) {
    G_LDB(B0, 0, 0); G_SCHED; G_LDA(At, 0, 0); G_STAGE(G_SA(1, 1), G_A1(t + 1), voffA);
    G_WAIT_L(8); G_BAR; G_WAIT_L(0); G_MMA(0, 0, At, B0); G_BAR; G_SCHED;
    G_LDB(B1, 0, 1); G_STAGE(G_SB(0, 0), G_B0(t + 2), voffB);
    G_BAR; G_WAIT_L(0); G_MMA(0, 1, At, B1); G_BAR;
    G_LDA(At, 0, 1); G_STAGE(G_SA(0, 0), G_A0(t + 2), voffA);
    G_BAR; G_WAIT_L(0); G_MMA(1, 0, At, B0); G_BAR; G_SCHED;
    G_STAGE(G_SB(0, 1), G_B1(t + 2), voffB);
    G_WAIT_V(6); G_BAR; G_MMA(1, 1, At, B1); G_BAR;
    G_LDB(B0, 1, 0); G_SCHED; G_LDA(At, 1, 0); G_STAGE(G_SA(0, 1), G_A1(t + 2), voffA);
    G_WAIT_L(8); G_BAR; G_WAIT_L(0); G_MMA(0, 0, At, B0); G_BAR; G_SCHED;
    G_LDB(B1, 1, 1); G_STAGE(G_SB(1, 0), G_B0(t + 3), voffB);
    G_BAR; G_WAIT_L(0); G_MMA(0, 1, At, B1); G_BAR;
    G_LDA(At, 1, 1); G_STAGE(G_SA(1, 0), G_A0(t + 3), voffA);
    G_BAR; G_WAIT_L(0); G_MMA(1, 0, At, B0); G_BAR; G_SCHED;
    G_STAGE(G_SB(1, 1), G_B1(t + 3), voffB);
    G_WAIT_V(6); G_BAR; G_MMA(1, 1, At, B1); G_BAR;
  }
  { G_LDB(B0, 0, 0); G_LDA(At, 0, 0); G_STAGE(G_SA(1, 1), G_A1(nt - 1), voffA);
    G_BAR; G_WAIT_L(0); G_MMA(0, 0, At, B0); G_BAR;
    G_LDB(B1, 0, 1); G_BAR; G_WAIT_L(0); G_MMA(0, 1, At, B1); G_BAR;
    G_LDA(At, 0, 1); G_WAIT_V(4); G_BAR; G_WAIT_L(0); G_MMA(1, 0, At, B0); G_MMA(1, 1, At, B1); G_BAR; }
  { G_LDB(B0, 1, 0); G_LDA(At, 1, 0); G_WAIT_V(2); G_BAR; G_WAIT_L(0); G_MMA(0, 0, At, B0); G_BAR;
    G_LDB(B1, 1, 1); G_WAIT_V(0); G_BAR; G_WAIT_L(0); G_MMA(0, 1, At, B1); G_BAR;
    G_LDA(At, 1, 1); G_BAR; G_WAIT_L(0); G_MMA(1, 0, At, B0); G_MMA(1, 1, At, B1); G_BAR; }
  if (wr == 0) G_BAR;
  asm volatile("" ::: "memory");
}

DI void gemm_prefetch(const bf16_t* Ap, long lda, long ksa, const bf16_t* Bp, long ldb, long ksb, LAS unsigned char* shm) {
  int tid_ = threadIdx.x; asm volatile("" : "+v"(tid_)); const int tid = tid_, wid = __builtin_amdgcn_readfirstlane(tid >> 6);
  int voffA[2], voffB[2];
#pragma unroll
  for (int i = 0; i < 2; ++i) { int R, C; stage_rc(tid * 16 + i * 8192, R, C); voffA[i] = R * (int)lda + C; voffB[i] = R * (int)ldb + C; }
  LAS unsigned char* ldsw = shm + wid * 1024;
  const long hA = 128 * lda, hB = 128 * ldb;
  G_STAGE(G_SB(0, 0), G_B0(0), voffB); G_STAGE(G_SA(0, 0), G_A0(0), voffA); G_STAGE(G_SB(0, 1), G_B1(0), voffB); G_STAGE(G_SA(0, 1), G_A1(0), voffA);
  G_STAGE(G_SB(1, 0), G_B0(1), voffB); G_STAGE(G_SA(1, 0), G_A0(1), voffA); G_STAGE(G_SB(1, 1), G_B1(1), voffB);
}

struct GUnit { const bf16_t* Ap; const bf16_t* Bp; int lda, ldb; long ksa, ksb; int nt, pm, pn, permB; };
#define G_STAGE2(bufoff, gp, v0, v1) do { const bf16_t* gp_ = (gp); glds16(gp_ + (v0), ldsw + (bufoff)); glds16(gp_ + (v1), ldsw + (bufoff) + 8192); } while (0)
template <class Seq>
DI void gemm_stream(const Seq& seq, LAS unsigned char* shm, const bool pre = false, const bool has_tail = false, const GUnit tail = GUnit{}) {
  int tid_ = threadIdx.x; asm volatile("" : "+v"(tid_)); const int tid = tid_, wid = __builtin_amdgcn_readfirstlane(tid >> 6), lane = tid & 63, wr = wid >> 2, wc = wid & 3, fr = lane & 15, fq = lane >> 4;
  int R0, C0, R1, C1; stage_rc(tid * 16, R0, C0); stage_rc(tid * 16 + 8192, R1, C1);
  const int aoff = lds_byte(wr * 64 + fr, fq * 8), boff = lds_byte(wc * 32 + fr, fq * 8);
  LAS unsigned char* ldsw = shm + wid * 1024;
  GUnit cur, nxt;
  if (!seq.get(0, cur)) return;
  f32x4 acc[2][2][4][2];
#pragma unroll
  for (int ai = 0; ai < 2; ++ai)
#pragma unroll
    for (int bj = 0; bj < 2; ++bj)
#pragma unroll
      for (int m = 0; m < 4; ++m)
#pragma unroll
        for (int n = 0; n < 2; ++n) acc[ai][bj][m][n] = (f32x4){0.f, 0.f, 0.f, 0.f};
  bf16x8 At[4][2], B0[2][2], B1[2][2];
  const int P0 = (R0 & ~31) + 8 * ((R0 & 15) >> 2) + 4 * ((R0 >> 4) & 1) + (R0 & 3), P1 = (R1 & ~31) + 8 * ((R1 & 15) >> 2) + 4 * ((R1 >> 4) & 1) + (R1 & 3);
  int va0 = R0 * cur.lda + C0, va1 = R1 * cur.lda + C1, vb0 = (cur.permB ? P0 : R0) * cur.ldb + C0, vb1 = (cur.permB ? P1 : R1) * cur.ldb + C1;
  G_WAIT_V(0);
  if (pre) { if (wr == 1) G_BAR; G_BAR; G_BAR; }
  else {
    const bf16_t* Ap = cur.Ap; const bf16_t* Bp = cur.Bp; const long hA = 128L * cur.lda, hB = 128L * cur.ldb;
    G_STAGE2(G_SB(0, 0), Bp, vb0, vb1); G_STAGE2(G_SB(0, 1), Bp + hB, vb0, vb1); G_STAGE2(G_SA(0, 0), Ap, va0, va1); G_STAGE2(G_SA(0, 1), Ap + hA, va0, va1);
    if (wr == 1) G_BAR;
    G_WAIT_V(2); G_BAR;
    G_STAGE2(G_SB(1, 0), Bp + cur.ksb, vb0, vb1); G_STAGE2(G_SA(1, 0), Ap + cur.ksa, va0, va1); G_STAGE2(G_SB(1, 1), Bp + hB + cur.ksb, vb0, vb1);
    G_WAIT_V(6); G_BAR;
  }
  for (int ui = 0;; ++ui) {
    const bool has_next = seq.get(ui + 1, nxt);
    if (!has_next) nxt = has_tail ? tail : cur;
    const int na0 = R0 * nxt.lda + C0, na1 = R1 * nxt.lda + C1, nb0 = (nxt.permB ? P0 : R0) * nxt.ldb + C0, nb1 = (nxt.permB ? P1 : R1) * nxt.ldb + C1;
    const long hA = 128L * cur.lda, hB = 128L * cur.ldb, nhA = 128L * nxt.lda, nhB = 128L * nxt.ldb;
    const int nt = cur.nt;
#pragma unroll 1
    for (int t = 0; t < nt; t += 2) {
      const bool last = t == nt - 2;
      const bf16_t* a1 = cur.Ap + (long)(t + 1) * cur.ksa;
      const bf16_t* a2 = last ? nxt.Ap : cur.Ap + (long)(t + 2) * cur.ksa; const bf16_t* b2 = last ? nxt.Bp : cur.Bp + (long)(t + 2) * cur.ksb;
      const bf16_t* a3 = a2 + (last ? nxt.ksa : cur.ksa); const bf16_t* b3 = b2 + (last ? nxt.ksb : cur.ksb);
      const long h2A = last ? nhA : hA, h2B = last ? nhB : hB;
      const int xa0 = last ? na0 : va0, xa1 = last ? na1 : va1, xb0 = last ? nb0 : vb0, xb1 = last ? nb1 : vb1;
      G_LDB(B0, 0, 0); G_LDB(B1, 0, 1); G_SCHED; G_LDA(At, 0, 0); G_STAGE2(G_SA(1, 1), a1 + hA, va0, va1);
      G_WAIT_V(8); G_WAIT_L(0); G_BAR; G_MMA(0, 0, At, B0); G_MMA(0, 1, At, B1); G_BAR; G_SCHED;
      G_LDA(At, 0, 1); G_STAGE2(G_SB(0, 0), b2, xb0, xb1); G_STAGE2(G_SB(0, 1), b2 + h2B, xb0, xb1); G_STAGE2(G_SA(0, 0), a2, xa0, xa1);
      G_WAIT_V(8); G_WAIT_L(0); G_BAR; G_MMA(1, 0, At, B0); G_MMA(1, 1, At, B1); G_BAR; G_SCHED;
      G_LDB(B0, 1, 0); G_LDB(B1, 1, 1); G_SCHED; G_LDA(At, 1, 0); G_STAGE2(G_SA(0, 1), a2 + h2A, xa0, xa1);
      G_WAIT_V(8); G_WAIT_L(0); G_BAR; G_MMA(0, 0, At, B0); G_MMA(0, 1, At, B1); G_BAR; G_SCHED;
      G_LDA(At, 1, 1); G_STAGE2(G_SB(1, 0), b3, xb0, xb1); G_STAGE2(G_SB(1, 1), b3 + h2B, xb0, xb1); G_STAGE2(G_SA(1, 0), a3, xa0, xa1);
      G_WAIT_V(8); G_WAIT_L(0); G_BAR; G_MMA(1, 0, At, B0); G_MMA(1, 1, At, B1); G_BAR; G_SCHED;
    }
    if (wr == 0) G_BAR;
    asm volatile("" ::: "memory");
    seq.epi(acc, cur);
    if (!has_next) break;
#pragma unroll
    for (int ai = 0; ai < 2; ++ai)
#pragma unroll
      for (int bj = 0; bj < 2; ++bj)
#pragma unroll
        for (int m = 0; m < 4; ++m)
#pragma unroll
          for (int n = 0; n < 2; ++n) acc[ai][bj][m][n] = (f32x4){0.f, 0.f, 0.f, 0.f};
    cur = nxt; va0 = na0; va1 = na1; vb0 = nb0; vb1 = nb1;
    if (wr == 1) G_BAR;
  }
  G_WAIT_V(0);
  __syncthreads();
}

DI bool tile_map(int i, int nM, int nN, int& pm, int& pn) {
  const int G = gridDim.x, c = blockIdx.x;
  if ((G & 7) == 0 && (nM & 63) == 0) {
    const int x = c & 7, loc = c >> 3, per = G >> 3, q = i * per + loc, total = (nM >> 3) * nN;
    if (q >= total) return false;
    const int g = q / (8 * nN), r = q % (8 * nN);
    pm = 8 * (g * 8 + (r & 7)) + x; pn = r >> 3; return true;
  }
  const long L = (long)i * G + c; if (L >= (long)nM * nN) return false;
  pm = (int)(L / nN); pn = (int)(L % nN); return true;
}

template <int MODE>
DI void conv_item(const float* src, const float* src2, const float* rs, bf16_t* dst, int K, int Nsrc, int nblk, LAS float* scr, int item, int lane) {
  const int kb = item / nblk, nb = item % nblk, k0 = 64 * kb, n0 = 32 * nb;
  const int n = n0 + (lane & 31);
  int col = n; float cs = 1.f; const float* s = src;
  if (MODE == 0) {
    if (n < 1024) { const int head = n >> 7, pp = n & 127, half = (pp >> 4) & 1, jj = pp >> 5, i = pp & 15; col = head * 128 + half * 64 + jj * 16 + i; if (n >= 512) cs = 0.08838834764831845f; }
    else if (n >= 3072 && n < 4096) { const int c = (n - 3072) & 255, base = n - c; col = base + 64 * ((c >> 5) & 3) + 32 * (c >> 7) + 8 * ((c & 15) >> 2) + 4 * ((c >> 4) & 1) + (c & 3); }
    else if ((n >= 2048 && n < 3072) || n >= 4608) { const int rho = n & 31; col = (n & ~31) + 8 * ((rho & 15) >> 2) + 4 * (rho >> 4) + (rho & 3); }
  } else if (MODE == 3) {
    const int rho = n & 31; col = (n & ~31) + 8 * ((rho & 15) >> 2) + 4 * (rho >> 4) + (rho & 3);
  } else if (MODE == 1) {
    const int c = n & 255, r7 = c & 127, rho = r7 & 31; col = (n >> 8) * 128 + (r7 & ~31) + 8 * ((rho & 15) >> 2) + 4 * (rho >> 4) + (rho & 3); if (c >> 7) s = src2;
  }
  const float* sp = s + (long)(k0 + (lane >> 5)) * Nsrc + col;
#pragma unroll 8
  for (int i = 0; i < 32; ++i) {
    const int kk = 2 * i + (lane >> 5);
    float w = sp[(long)(2 * i) * Nsrc] * cs;
    if (rs) w *= rs[k0 + kk];
    scr[kk * 33 + (lane & 31)] = w;
  }
  asm volatile("s_waitcnt lgkmcnt(0)" ::: "memory");
  const int c = lane & 7;
#pragma unroll
  for (int j = 0; j < 4; ++j) {
    const int nn = (lane >> 3) + 8 * j; const LAS float* q = scr + (8 * c) * 33 + nn;
    u32x4 o; o.x = pk2(q[0], q[33]); o.y = pk2(q[2 * 33], q[3 * 33]); o.z = pk2(q[4 * 33], q[5 * 33]); o.w = pk2(q[6 * 33], q[7 * 33]);
    *(u32x4*)(dst + (long)(n0 + nn) * K + k0 + 8 * c) = o;
  }
  asm volatile("s_waitcnt lgkmcnt(0)" ::: "memory");
}

DI void phase0(const Params& p, LAS unsigned char* shm, int part = 7) {
  unsigned char* ws = p.ws;
  const long gtid = (long)blockIdx.x * NTHREADS + threadIdx.x, nthr = (long)gridDim.x * NTHREADS;
  const int lane = threadIdx.x & 63, wv = threadIdx.x >> 6, gw = blockIdx.x * 8 + wv, ngw = gridDim.x * 8;
  if (part & 1) {
    bf16_t* xb = (bf16_t*)((unsigned char*)p.out + 64 * MiB);
    float* rstd1 = (float*)(ws + OFF_RSTD1);
    for (int r0 = gw * 4; r0 < T_TOK; r0 += ngw * 4) {
      f32x4 v[4][4];
#pragma unroll
      for (int rr = 0; rr < 4; ++rr) {
        const f32x4* xr = (const f32x4*)(p.x + (long)(r0 + rr) * DM) + lane;
#pragma unroll
        for (int j = 0; j < 4; ++j) v[rr][j] = xr[64 * j];
      }
#pragma unroll
      for (int rr = 0; rr < 4; ++rr) {
        float s = 0.f;
#pragma unroll
        for (int j = 0; j < 4; ++j) s += v[rr][j][0] * v[rr][j][0] + v[rr][j][1] * v[rr][j][1] + v[rr][j][2] * v[rr][j][2] + v[rr][j][3] * v[rr][j][3];
#pragma unroll
        for (int o = 1; o < 64; o <<= 1) s += __shfl_xor(s, o);
        if (lane == 0) { const float rv = 1.0f / sqrtf(s * (1.0f / DM) + 1e-6f); const int r = r0 + rr, rl = r & 255;
          rstd1[r] = rv; ((float*)(ws + OFF_RSTD1Q))[(r & ~255) + (((rl >> 6) & 1) * 16 + (rl & 15)) * 8 + (rl >> 7) * 4 + ((rl >> 4) & 3)] = rv; }
        u32x2* o8 = (u32x2*)(xb + (long)(r0 + rr) * DM) + lane;
#pragma unroll
        for (int j = 0; j < 4; ++j) o8[64 * j] = pk4(v[rr][j]);
      }
    }
  }
  if (part & 2) {
    LAS float* scr = (LAS float*)shm + wv * (64 * 33);
    constexpr int I0 = 16 * 208, I1 = 16 * 32, I2 = 8 * 32, I3 = 16 * 32, I4 = 16 * 176, I5 = 44 * 32;
    for (int it = gw; it < I0 + I1 + I2 + I3 + I4 + I5; it += ngw) {
      int r = it;
      if (r < I0) { conv_item<0>(p.w_in, nullptr, p.norm1_w, (bf16_t*)(ws + OFF_WIN), 1024, NCOL, 208, scr, r, lane); continue; } r -= I0;
      if (r < I1) { conv_item<3>(p.w_ret_out, nullptr, nullptr, (bf16_t*)(ws + OFF_WRO), 1024, 1024, 32, scr, r, lane); continue; } r -= I1;
      if (r < I2) { conv_item<3>(p.w_moba_out, nullptr, nullptr, (bf16_t*)(ws + OFF_WMO), 512, 1024, 32, scr, r, lane); continue; } r -= I2;
      if (r < I3) { conv_item<3>(p.w_o, nullptr, nullptr, (bf16_t*)(ws + OFF_WO), 1024, 1024, 32, scr, r, lane); continue; } r -= I3;
      if (r < I4) { conv_item<1>(p.w_gate, p.w_up, p.norm2_w, (bf16_t*)(ws + OFF_WGU), 1024, FH, 176, scr, r, lane); continue; } r -= I4;
      conv_item<2>(p.w_down, nullptr, nullptr, (bf16_t*)(ws + OFF_WD), FH, 1024, 32, scr, r, lane);
    }
  }
  if (part & 4) {
    float* cosT = (float*)(ws + OFF_COS); float* sinT = (float*)(ws + OFF_SIN);
    for (long idx = gtid; idx < (long)SEQ * 64; idx += nthr) {
      const int pos = (int)(idx >> 6), j = (int)(idx & 63);
      const float inv = exp2f(-(float)j * (13.287712379549449f / 64.0f));
      const float ang = (float)pos * inv;
      const double rev = (double)ang * 0.15915494309189535;
      const float fr = (float)(rev - __builtin_rint(rev));
      cosT[idx] = __builtin_amdgcn_cosf(fr); sinT[idx] = __builtin_amdgcn_sinf(fr);
    }
  }
  if (blockIdx.x == 0 && threadIdx.x < 64) {
    float a = fabsf(p.q_norm_w[threadIdx.x]), b = fabsf(p.k_norm_w[threadIdx.x]);
#pragma unroll
    for (int o = 1; o < 64; o <<= 1) { a = fmaxf(a, __shfl_xor(a, o)); b = fmaxf(b, __shfl_xor(b, o)); }
    if (threadIdx.x == 0) ((float*)(ws + OFF_SC))[0] = 8.0f * a * b * 1.01f;
  }
}

template <int REG>
DI void epi_inproj(const Params& p, f32x4 (&acc)[2][2][4][2], int pm, int pn, LAS unsigned char* shm) {
  unsigned char* ws = p.ws;
  int tid_ = threadIdx.x; asm volatile("" : "+v"(tid_)); const int tid = tid_, wid = tid >> 6, lane = tid & 63, wr = wid >> 2, wc = wid & 3, fr = lane & 15, fq = lane >> 4;
  const int b = pm >> 5, blk = pm & 31, t0 = blk * 256, T0 = pm * 256;
  const float* rstd1 = (const float*)(ws + OFF_RSTD1);
  float rsr[2][4];
  if (REG != 1) {
#pragma unroll
    for (int ai = 0; ai < 2; ++ai)
#pragma unroll
      for (int m = 0; m < 4; ++m) rsr[ai][m] = 0.f;
    const f32x4 q0 = *(const f32x4*)((const float*)(ws + OFF_RSTD1Q) + T0 + (wr * 16 + fr) * 8), q1 = *(const f32x4*)((const float*)(ws + OFF_RSTD1Q) + T0 + (wr * 16 + fr) * 8 + 4);
#pragma unroll
    for (int m = 0; m < 4; ++m) { rsr[0][m] = q0[m]; rsr[1][m] = q1[m]; }
  }
  if (REG == 0) {
    const bool isk = pn >= 2;
    const float* cosT = (const float*)(ws + OFF_COS); const float* sinT = (const float*)(ws + OFF_SIN);
    bf16_t* dstb = (bf16_t*)(ws + (isk ? OFF_KR : OFF_QR));
    bf16_t* krt = (bf16_t*)(ws + OFF_KRT);
#pragma unroll
    for (int ai = 0; ai < 2; ++ai)
#pragma unroll
      for (int m = 0; m < 4; ++m) { asm volatile("" ::: "memory");
        const int r = 128 * ai + 64 * wr + 16 * m + fr, t = t0 + r;
        const float rs = rsr[ai][m];
        const f32x4 cs = *(const f32x4*)(cosT + t * 64 + 16 * wc + 4 * fq), sn = *(const f32x4*)(sinT + t * 64 + 16 * wc + 4 * fq);
#pragma unroll
        for (int bj = 0; bj < 2; ++bj) {
          const int h = 2 * (pn & 1) + bj;
          const float sc = fast_exp2((isk ? -1.f : 1.f) * (float)(t & 127) * lg2gamma(h)) * rs;
          const f32x4 x1 = acc[ai][bj][m][0] * sc, x2 = acc[ai][bj][m][1] * sc;
          const f32x4 y1 = x1 * cs - x2 * sn, y2 = x2 * cs + x1 * sn;
          const int d = 16 * wc + 4 * fq;
          const int tl2 = t & 127, r32 = tl2 & 31;
          const int frag = isk ? (((tl2 >> 5) * 2 + ((r32 >> 2) & 1)) * 4 + (d >> 5)) : ((tl2 >> 4) * 4 + (d >> 5));
          const int frl = isk ? ((r32 >> 3) * 4 + (r32 & 3)) : (tl2 & 15);
          bf16_t* dst = dstb + ((long)((b * 4 + h) * 64 + (t >> 7))) * 16384 + (frag * 64 + ((d >> 3) & 3) * 16 + frl) * 8 + (d & 7);
          const u32x2 o1 = pk4(y1), o2 = pk4(y2);
          *(u32x2*)dst = o1; *(u32x2*)(dst + 2 * 512) = o2;
          if (isk) {
            LAS unsigned char* tb = shm + 135168 + wid * 1024;
            LAS bf16_t* w1 = (LAS bf16_t*)(tb + (4 * fq) * 32 + fr * 2);
            w1[0] = (bf16_t)(o1.x & 0xffff); w1[16] = (bf16_t)(o1.x >> 16); w1[32] = (bf16_t)(o1.y & 0xffff); w1[48] = (bf16_t)(o1.y >> 16);
            LAS bf16_t* w2 = w1 + 16 * 16;
            w2[0] = (bf16_t)(o2.x & 0xffff); w2[16] = (bf16_t)(o2.x >> 16); w2[32] = (bf16_t)(o2.y & 0xffff); w2[48] = (bf16_t)(o2.y >> 16);
            asm volatile("s_waitcnt lgkmcnt(0)" ::: "memory");
            const int dl = lane >> 1, th = lane & 1;
            const u32x4 kv = *(const LAS u32x4*)(tb + dl * 32 + th * 16);
            asm volatile("" ::: "memory");
            const int dd = dl < 16 ? 16 * wc + dl : 48 + 16 * wc + dl;
            const int tb0 = t0 + 128 * ai + 64 * wr + 16 * m + 8 * th, tl = tb0 & 127;
            *(u32x4*)(krt + ((long)((b * 4 + h) * 64 + (tb0 >> 7))) * 16384 + (((dd >> 4) * 4 + (tl >> 5)) * 64 + ((tl >> 3) & 3) * 16 + (dd & 15)) * 8) = kv;
          }
        }
      }
  } else if (REG == 1) {
    const bool isr = pn < 8;
    f32x4 rs4[2][2];
#pragma unroll
    for (int bj = 0; bj < 2; ++bj)
#pragma unroll
      for (int n = 0; n < 2; ++n) rs4[bj][n] = *(const f32x4*)(rstd1 + T0 + 128 * bj + 32 * wc + 8 * fq + 4 * n);
#pragma unroll
    for (int bj = 0; bj < 2; ++bj) {
      const int cB = 128 * bj + 32 * wc + 8 * fq;
#pragma unroll
      for (int ai = 0; ai < 2; ++ai)
#pragma unroll
        for (int m = 0; m < 4; ++m) { asm volatile("" ::: "memory");
          const int rA = 128 * ai + 64 * wr + 16 * m + fr;
          bf16_t* dst;
          if (isr) { const int tl = cB & 127;
            dst = (bf16_t*)(ws + OFF_VRT) + ((long)((b * 4 + (pn - 4)) * 64 + 2 * blk + (cB >> 7))) * 32768 + (((rA >> 4) * 4 + (tl >> 5)) * 64 + ((tl >> 3) & 3) * 16 + (rA & 15)) * 8; }
          else dst = (bf16_t*)(ws + OFF_MVT) + ((long)(((b * 8 + (pn - 16) * 4 + (rA >> 6)) * 32 + blk) * 64 + (rA & 63))) * 256 + cB;
          const u32x2 h0 = pk4(acc[ai][bj][m][0] * rs4[bj][0]), h1 = pk4(acc[ai][bj][m][1] * rs4[bj][1]);
          *(u32x4*)dst = (u32x4){h0.x, h0.y, h1.x, h1.y};
        }
    }
  } else if (REG == 2) {
    bf16_t* dstb; int cb;
    if (pn < 12) { dstb = (bf16_t*)(ws + OFF_G); cb = (pn - 8) * 256; }
    else if (pn < 22) { dstb = (bf16_t*)(ws + OFF_GA); cb = (pn - 18) * 256; }
    else { dstb = (bf16_t*)(ws + OFF_GB); cb = (pn - 22) * 256; }
    const bool silu = pn < 12;
#pragma unroll
    for (int ai = 0; ai < 2; ++ai)
#pragma unroll
      for (int m = 0; m < 4; ++m) { asm volatile("" ::: "memory");
        const int r = 128 * ai + 64 * wr + 16 * m + fr;
        const float rs = rsr[ai][m];
#pragma unroll
        for (int bj = 0; bj < 2; ++bj) {
          u32x2 h[2];
#pragma unroll
          for (int n = 0; n < 2; ++n) {
            f32x4 v = acc[ai][bj][m][n] * rs, o;
#pragma unroll
            for (int j = 0; j < 4; ++j) { const float sg = sigmoidf_(v[j]); o[j] = silu ? v[j] * sg : sg; }
            h[n] = pk4(o);
          }
          *(u32x4*)(dstb + (long)(T0 + r) * 1024 + cb + 128 * bj + 32 * wc + 8 * fq) = (u32x4){h[0].x, h[0].y, h[1].x, h[1].y};
        }
      }
  } else {
    const bool isk = pn >= 14;
    const float* nw = isk ? p.k_norm_w : p.q_norm_w;
    bf16_t* dstb = (bf16_t*)(ws + (isk ? OFF_MK : OFF_MQ));
    const int hh = (pn & 1) * 4 + wc;
    f32x4 w4[2][2], cs4[2][2];
#pragma unroll
    for (int bj = 0; bj < 2; ++bj)
#pragma unroll
      for (int n = 0; n < 2; ++n) { w4[bj][n] = *(const f32x4*)(nw + 32 * bj + 8 * fq + 4 * n); cs4[bj][n] = (f32x4){0.f, 0.f, 0.f, 0.f}; }
#pragma unroll
    for (int ai = 0; ai < 2; ++ai)
#pragma unroll
      for (int m = 0; m < 4; ++m) { asm volatile("" ::: "memory");
        const int r = 128 * ai + 64 * wr + 16 * m + fr, t = t0 + r;
        const float rs = rsr[ai][m];
        f32x4 v[2][2]; float ss = 0.f;
#pragma unroll
        for (int bj = 0; bj < 2; ++bj)
#pragma unroll
          for (int n = 0; n < 2; ++n) { v[bj][n] = acc[ai][bj][m][n] * rs; ss += v[bj][n][0] * v[bj][n][0] + v[bj][n][1] * v[bj][n][1] + v[bj][n][2] * v[bj][n][2] + v[bj][n][3] * v[bj][n][3]; }
        ss += __shfl_xor(ss, 16); ss += __shfl_xor(ss, 32);
        const float rn = __builtin_amdgcn_rsqf(ss * (1.0f / 64.0f) + 1e-6f) * (isk ? 1.0f : 0.125f * 1.4426950408889634f);
        bf16_t* dst = dstb + ((long)((b * 8 + hh) * SEQ + t)) * 64 + 8 * fq;
#pragma unroll
        for (int bj = 0; bj < 2; ++bj) {
          const f32x4 o0 = v[bj][0] * rn * w4[bj][0], o1 = v[bj][1] * rn * w4[bj][1]; cs4[bj][0] += o0; cs4[bj][1] += o1;
          const u32x2 h0 = pk4(o0), h1 = pk4(o1);
          *(u32x4*)(dst + 32 * bj) = (u32x4){h0.x, h0.y, h1.x, h1.y};
        }
      }
    if (isk) {
      LAS float* red = (LAS float*)(shm + 131072);
#pragma unroll
      for (int bj = 0; bj < 2; ++bj)
#pragma unroll
        for (int n = 0; n < 2; ++n)
#pragma unroll
          for (int j = 0; j < 4; ++j) {
            float s = cs4[bj][n][j];
            s += __shfl_xor(s, 1); s += __shfl_xor(s, 2); s += __shfl_xor(s, 4); s += __shfl_xor(s, 8);
            if (fr == 0) red[wr * 256 + wc * 64 + 32 * bj + 8 * fq + 4 * n + j] = s;
          }
      __syncthreads();
      if (tid < 256) {
        float* kbar = (float*)(ws + OFF_KBAR);
        kbar[((long)((b * 8 + (pn & 1) * 4 + (tid >> 6)) * 32 + blk)) * 64 + (tid & 63)] = (red[tid] + red[256 + tid]) * (1.0f / 256.0f);
      }
      __syncthreads();
    }
  }
}

template <int REG>
struct SeqInproj {
  const Params& p; const bf16_t* xb; const bf16_t* W; LAS unsigned char* shm;
  static constexpr int NN = REG == 0 ? 4 : (REG == 1 ? 6 : (REG == 2 ? 12 : 4));
  DI bool get(int i, GUnit& u) const {
    int pm, ix;
    if (!tile_map(i, 128, NN, pm, ix)) return false;
    const int pn = REG == 0 ? ix : (REG == 1 ? (ix < 4 ? 4 + ix : 12 + ix) : (REG == 2 ? (ix < 4 ? 8 + ix : 14 + ix) : 12 + ix));
    const bf16_t* a = xb + (long)pm * 256 * DM; const bf16_t* b = W + (long)pn * 256 * DM;
    u.Ap = REG == 1 ? b : a; u.Bp = REG == 1 ? a : b; u.lda = DM; u.ldb = DM; u.ksa = 64; u.ksb = 64; u.nt = 16; u.pm = pm; u.pn = pn; u.permB = REG == 1;
    return true;
  }
  DI void epi(f32x4 (&acc)[2][2][4][2], const GUnit& u) const { epi_inproj<REG>(p, acc, u.pm, u.pn, shm); }
};
template <int REG>
DI void phase1_region(const Params& p, LAS unsigned char* shm) {
  const SeqInproj<REG> seq{p, (const bf16_t*)((unsigned char*)p.out + 64 * MiB), (const bf16_t*)(p.ws + OFF_WIN), shm};
  gemm_stream(seq, shm);
}
DI void phase1(const Params& p, LAS unsigned char* shm) {
  const bf16_t* xb = (const bf16_t*)((unsigned char*)p.out + 64 * MiB); const bf16_t* W = (const bf16_t*)(p.ws + OFF_WIN);
  bool pre = false;
  { const SeqInproj<2> s{p, xb, W, shm}; const SeqInproj<1> sn{p, xb, W, shm}; GUnit t, t0; const bool h = s.get(0, t0), hn = sn.get(0, t); gemm_stream(s, shm, pre, h && hn, t); pre = h && hn; }
  { const SeqInproj<1> s{p, xb, W, shm}; const SeqInproj<0> sn{p, xb, W, shm}; GUnit t, t0; const bool h = s.get(0, t0), hn = sn.get(0, t); gemm_stream(s, shm, pre, h && hn, t); pre = h && hn; }
  { const SeqInproj<0> s{p, xb, W, shm}; const SeqInproj<3> sn{p, xb, W, shm}; GUnit t, t0; const bool h = s.get(0, t0), hn = sn.get(0, t); gemm_stream(s, shm, pre, h && hn, t); pre = h && hn; }
  { const SeqInproj<3> s{p, xb, W, shm}; gemm_stream(s, shm, pre); }
}

DI void ret_scan(const Params& p, LAS unsigned char* shm) {
  unsigned char* ws = p.ws;
  int tid_ = threadIdx.x; asm volatile("" : "+v"(tid_)); const int tid = tid_, wid = tid >> 6, lane = tid & 63, fr = lane & 15, fq = lane >> 4;
  const bf16_t* Vrt = (const bf16_t*)(ws + OFF_VRT); const bf16_t* Krt = (const bf16_t*)(ws + OFF_KRT);
  bf16_t* RT = (bf16_t*)p.out;
  LAS bf16_t* stg = (LAS bf16_t*)shm;
  for (int u0 = blockIdx.x; u0 < 256; u0 += gridDim.x) {
    int u = u0;
    if (gridDim.x == 256) { const int x = u0 & 7, m = u0 >> 3; u = (2 * x + (m >> 4)) * 16 + (m & 15); }
    const int bh = u >> 4, e0 = (u & 15) * 16, h = bh & 3;
    const float lg = lg2gamma(h), g128 = exp2f(128.f * lg), g127 = exp2f(127.f * lg);
    const bf16_t* vp = Vrt + (long)(bh * 64) * 32768 + (e0 >> 4) * 2048 + lane * 8;
    const bf16_t* kp = Krt + (long)(bh * 64) * 16384 + wid * 2048 + lane * 8;
    f32x4 st = {0.f, 0.f, 0.f, 0.f};
    bf16x8 vb[4][4], kb[4][4];
#pragma unroll
    for (int r = 0; r < 4; ++r)
#pragma unroll
      for (int ks = 0; ks < 4; ++ks) { vb[r][ks] = *(const bf16x8*)(vp + r * 32768 + ks * 512); kb[r][ks] = *(const bf16x8*)(kp + r * 16384 + ks * 512); }
#pragma unroll 1
    for (int c0 = 0; c0 < 64; c0 += 8) {
#pragma unroll
      for (int s = 0; s < 8; ++s) {
        const int r = s & 3, c = c0 + s;
        LAS bf16_t* sp = stg + (s * 16 + 4 * fq) * 136 + 16 * wid + fr;
        sp[0] = f2bf(st[0]); sp[136] = f2bf(st[1]); sp[272] = f2bf(st[2]); sp[408] = f2bf(st[3]);
        f32x4 uacc = {0.f, 0.f, 0.f, 0.f};
#pragma unroll
        for (int ks = 0; ks < 4; ++ks) uacc = MFMA16(vb[r][ks], kb[r][ks], uacc);
        st = st * g128 + uacc * g127;
        const int cn = c + 4 < 64 ? c + 4 : 63;
#pragma unroll
        for (int ks = 0; ks < 4; ++ks) { vb[r][ks] = *(const bf16x8*)(vp + cn * 32768 + ks * 512); kb[r][ks] = *(const bf16x8*)(kp + cn * 16384 + ks * 512); }
      }
      __syncthreads();
#pragma unroll
      for (int i = 0; i < 4; ++i) {
        const int pc = tid + i * NTHREADS, s = pc >> 8, ch = (pc >> 4) & 15, el = pc & 15;
        const u32x4 v = *(const LAS u32x4*)(stg + (s * 16 + el) * 136 + ch * 8);
        *(u32x4*)(RT + (long)(bh * 64 + c0 + s) * 32768 + ((((e0 >> 4) * 4 + (ch >> 2)) * 64 + (ch & 3) * 16 + el) * 8)) = v;
      }
      __syncthreads();
    }
  }
}

constexpr int MO_QS = 144;
constexpr int MO_OACC = 0, MO_L = 256 * 64 * 4, MO_CNT = MO_L + 1024, MO_LIST = MO_CNT + 128, MO_Q = MO_LIST + 32 * 256, MO_P = MO_Q + 256 * MO_QS, MO_KBAR = MO_P, MO_END = MO_P + 32768;
static_assert(MO_END <= LDS_BYTES, "moba lds");
DI int mo_oidx(int q, int d4) { return q * 64 + ((d4 ^ (q & 15)) << 2); }

DI void moba_loadkv(const bf16_t* Mk, const bf16_t* Mvt, long krow0, long vrow, int j, int w, int fr, int fq, bf16x8 (&kf)[2][2], bf16x8 (&vf)[8]) {
  const int prow = (fr >> 2) * 8 + (fr & 3);
  const bf16_t* kp = Mk + (krow0 + j * 256 + 32 * w + prow) * 64 + fq * 8;
  kf[0][0] = *(const bf16x8*)kp; kf[0][1] = *(const bf16x8*)(kp + 32); kf[1][0] = *(const bf16x8*)(kp + 256); kf[1][1] = *(const bf16x8*)(kp + 288);
  const bf16_t* vp = Mvt + vrow + ((long)j * 64 + (w & 3) * 16 + fr) * 256 + fq * 8;
#pragma unroll
  for (int ks = 0; ks < 8; ++ks) vf[ks] = *(const bf16x8*)(vp + ks * 32);
}

DI void moba_phase(const Params& p, LAS unsigned char* shm, int mode = 0) {
  const bool dry = mode != 0;
  unsigned char* ws = p.ws;
  int tid_ = threadIdx.x; asm volatile("" : "+v"(tid_)); const int tid = tid_, wid = __builtin_amdgcn_readfirstlane(tid >> 6), lane = tid & 63, fr = lane & 15, fq = lane >> 4;
  const bf16_t* Mk = (const bf16_t*)(ws + OFF_MK); const bf16_t* Mvt = (const bf16_t*)(ws + OFF_MVT);
  bf16_t* Mq = (bf16_t*)(ws + OFF_MQ);
  const float* kbarg = (const float*)(ws + OFF_KBAR);
  const float mb = ((const float*)(ws + OFF_SC))[0];
  const float c2 = mb * 1.4426950408889634f;
  LAS float* oacc = (LAS float*)(shm + MO_OACC); LAS float* lsl = (LAS float*)(shm + MO_L); LAS float* kb = (LAS float*)(shm + MO_KBAR);
  LAS int* cnt = (LAS int*)(shm + MO_CNT); LAS unsigned char* list = shm + MO_LIST; LAS unsigned char* Qs = shm + MO_Q; LAS unsigned char* Pb = shm + MO_P;
  const int dtw = wid & 3, ttw = wid >> 2;
  for (int u = blockIdx.x, it = 0; u < 1024; u += gridDim.x, ++it) {
    int blk = 31 - (u >> 5), bh = u & 31;
    if (gridDim.x == 256) {
      const int x = blockIdx.x & 7, m = blockIdx.x >> 3, m2 = (m + 16) & 31;
      bh = x + 8 * it; blk = it == 0 ? 31 - m : (it == 1 ? m : (it == 2 ? m2 : 31 - m2));
    }
    const long qbase = ((long)bh * SEQ + blk * 256) * 64;
    for (int i = tid; i < 256 * 64; i += NTHREADS) oacc[i] = 0.f;
    if (tid < 256) lsl[tid] = 0.f;
    if (tid < 32) cnt[tid] = 0;
    for (int i = tid; i < blk * 64; i += NTHREADS) kb[i] = kbarg[((long)bh * 32) * 64 + i];
    const int qt = tid >> 1, qh = tid & 1;
    u32x4 qw[4];
    {
      const u32x4* qp = (const u32x4*)(Mq + qbase + (long)qt * 64 + qh * 32);
#pragma unroll
      for (int i = 0; i < 4; ++i) { qw[i] = qp[i]; *(LAS u32x4*)(Qs + qt * MO_QS + qh * 64 + i * 16) = qw[i]; }
    }
    __syncthreads();
    if (blk > 0) {
      float q[32];
#pragma unroll
      for (int i = 0; i < 4; ++i) { const u32x4 w4 = qw[i]; q[8 * i] = __uint_as_float(w4.x << 16); q[8 * i + 1] = __uint_as_float(w4.x & 0xffff0000u); q[8 * i + 2] = __uint_as_float(w4.y << 16); q[8 * i + 3] = __uint_as_float(w4.y & 0xffff0000u);
        q[8 * i + 4] = __uint_as_float(w4.z << 16); q[8 * i + 5] = __uint_as_float(w4.z & 0xffff0000u); q[8 * i + 6] = __uint_as_float(w4.w << 16); q[8 * i + 7] = __uint_as_float(w4.w & 0xffff0000u); }
      float v0 = -3e38f, v1 = -3e38f, v2 = -3e38f; int i0 = -1, i1 = -1, i2 = -1;
      for (int j = 0; j < blk; ++j) {
        float g0 = 0.f, g1 = 0.f;
#pragma unroll
        for (int d = 0; d < 32; d += 8) { const f32x4 k4 = *(const LAS f32x4*)(kb + j * 64 + qh * 32 + d), k5 = *(const LAS f32x4*)(kb + j * 64 + qh * 32 + d + 4);
          g0 += q[d] * k4[0] + q[d + 1] * k4[1] + q[d + 2] * k4[2] + q[d + 3] * k4[3]; g1 += q[d + 4] * k5[0] + q[d + 5] * k5[1] + q[d + 6] * k5[2] + q[d + 7] * k5[3]; }
        float g = g0 + g1;
        g += __shfl_xor(g, 1);
        if (g > v0) { v2 = v1; i2 = i1; v1 = v0; i1 = i0; v0 = g; i0 = j; }
        else if (g > v1) { v2 = v1; i2 = i1; v1 = g; i1 = j; }
        else if (g > v2) { v2 = g; i2 = j; }
      }
      if (qh == 0) {
        if (i0 >= 0) { const int pz = atomicAdd((int*)(cnt + i0), 1); list[i0 * 256 + pz] = (unsigned char)qt; }
        if (i1 >= 0) { const int pz = atomicAdd((int*)(cnt + i1), 1); list[i1 * 256 + pz] = (unsigned char)qt; }
        if (i2 >= 0) { const int pz = atomicAdd((int*)(cnt + i2), 1); list[i2 * 256 + pz] = (unsigned char)qt; }
      }
    }
    __syncthreads();
    const long krow0 = (long)bh * SEQ, vrow = (long)bh * 64 * SEQ;
#define MO_BARRIER do { asm volatile("s_waitcnt lgkmcnt(0)" ::: "memory"); __builtin_amdgcn_s_barrier(); asm volatile("" ::: "memory"); } while (0)
    if (mode != 2) {
      if (wid >= 4) {
        const int sw = wid & 3, prow = (fr >> 2) * 8 + (fr & 3);
        bf16x8 kf[4][2], kn[4][2];
#pragma unroll
        for (int a = 0; a < 4; ++a) { kf[a][0] = (bf16x8){0, 0, 0, 0, 0, 0, 0, 0}; kf[a][1] = kf[a][0]; }
        int stepc = 0;
        auto ssteps = [&](const int j, auto ownc) {
          constexpr bool own = decltype(ownc)::value;
          const int n = j < 0 ? 0 : (own ? 256 : cnt[j]), ntile = (n + 15) >> 4;
          for (int s0 = 0; s0 < ntile; s0 += 2, ++stepc) {
            LAS unsigned char* pbuf = Pb + (stepc & 1) * 16384;
            if (!(mode & 4))
#pragma unroll
            for (int tt = 0; tt < 2; ++tt) {
              const int tile = s0 + tt;
              if (tile < ntile) {
                const int rem = n - tile * 16;
                const int qidx = own ? tile * 16 + fr : (int)list[j * 256 + tile * 16 + (fr < rem ? fr : 0)];
                const bf16x8 q0 = *(const LAS bf16x8*)(Qs + qidx * MO_QS + fq * 16), q1 = *(const LAS bf16x8*)(Qs + qidx * MO_QS + 64 + fq * 16);
#pragma unroll
                for (int g = 0; g < 2; ++g) {
                  f32x4 sv[2];
#pragma unroll
                  for (int par = 0; par < 2; ++par) { sv[par] = MFMA16(kf[g * 2 + par][0], q0, ((f32x4){0.f, 0.f, 0.f, 0.f})); sv[par] = MFMA16(kf[g * 2 + par][1], q1, sv[par]); }
                  float pv[2][4];
#pragma unroll
                  for (int par = 0; par < 2; ++par)
#pragma unroll
                    for (int i = 0; i < 4; ++i) {
                      float pe = fast_exp2(sv[par][i] - c2);
                      if (own) { const int key = 64 * sw + 32 * g + fq * 8 + 4 * par + i; if (key > qidx) pe = 0.f; }
                      pv[par][i] = pe;
                    }
                  u32x4 pw; pw.x = pk2(pv[0][0], pv[0][1]); pw.y = pk2(pv[0][2], pv[0][3]); pw.z = pk2(pv[1][0], pv[1][1]); pw.w = pk2(pv[1][2], pv[1][3]);
                  *(LAS u32x4*)(pbuf + tt * 8192 + (2 * sw + g) * 1024 + lane * 16) = pw;
                }
              }
            }
            MO_BARRIER;
          }
        };
        for (int j = -1; j < blk; ++j) {
          {
            const bf16_t* kp = Mk + (krow0 + (j + 1) * 256 + 64 * sw + prow) * 64 + fq * 8;
#pragma unroll
            for (int g = 0; g < 2; ++g)
#pragma unroll
              for (int par = 0; par < 2; ++par) { kn[g * 2 + par][0] = *(const bf16x8*)(kp + (32 * g + 4 * par) * 64); kn[g * 2 + par][1] = *(const bf16x8*)(kp + (32 * g + 4 * par) * 64 + 32); }
          }
          ssteps(j, std::false_type{});
#pragma unroll
          for (int a = 0; a < 4; ++a) { kf[a][0] = kn[a][0]; kf[a][1] = kn[a][1]; }
        }
        ssteps(blk, std::true_type{});
        MO_BARRIER;
      } else {
        const int ptt = wid >> 1, dh = wid & 1;
        bf16x8 vf[2][8], vn[2][8];
#pragma unroll
        for (int a = 0; a < 2; ++a)
#pragma unroll
          for (int ks = 0; ks < 8; ++ks) vf[a][ks] = (bf16x8){0, 0, 0, 0, 0, 0, 0, 0};
        int stepc = 0;
        auto psteps = [&](const int j, auto ownc) {
          constexpr bool own = decltype(ownc)::value;
          const int n = j < 0 ? 0 : (own ? 256 : cnt[j]), ntile = (n + 15) >> 4;
          for (int s0 = 0; s0 < ntile; s0 += 2, ++stepc) {
            const LAS unsigned char* pbuf = Pb + (stepc & 1) * 16384;
            const int tile = s0 + ptt;
            if (tile < ntile && !(mode & 8)) {
              const int rem = n - tile * 16;
              const bool qv = fr < rem;
              const int qidx = own ? tile * 16 + fr : (int)list[j * 256 + tile * 16 + (qv ? fr : 0)];
              u32x4 pw[8];
#pragma unroll
              for (int ks = 0; ks < 8; ++ks) pw[ks] = *(const LAS u32x4*)(pbuf + ptt * 8192 + ks * 1024 + lane * 16);
              LAS f32x4* op0 = (LAS f32x4*)(oacc + mo_oidx(qidx, dh * 8 + fq)); LAS f32x4* op1 = (LAS f32x4*)(oacc + mo_oidx(qidx, dh * 8 + 4 + fq));
              const f32x4 a0 = *op0, a1 = *op1; const float al = lsl[qidx];
              __builtin_amdgcn_sched_barrier(0);
              f32x4 o0 = {0.f, 0.f, 0.f, 0.f}, o1 = {0.f, 0.f, 0.f, 0.f}, ol = {0.f, 0.f, 0.f, 0.f};
              const bf16x8 ones = {0x3F80, 0x3F80, 0x3F80, 0x3F80, 0x3F80, 0x3F80, 0x3F80, 0x3F80};
#pragma unroll
              for (int ks = 0; ks < 8; ++ks) {
                const bf16x8 pb = __builtin_bit_cast(bf16x8, pw[ks]);
                o0 = MFMA16(vf[0][ks], pb, o0); o1 = MFMA16(vf[1][ks], pb, o1);
                if (dh == 0) ol = MFMA16(ones, pb, ol);
              }
              if (qv) {
                *op0 = a0 + o0; *op1 = a1 + o1;
                if (dh == 0 && fq == 0) lsl[qidx] = al + ol[0];
              }
            }
            MO_BARRIER;
          }
        };
        bool first = true;
        for (int j = -1; j < blk; ++j) {
          {
            const bf16_t* vp = Mvt + vrow + ((long)(j + 1) * 64 + dh * 32 + fr) * 256 + fq * 8;
#pragma unroll
            for (int a = 0; a < 2; ++a)
#pragma unroll
              for (int ks = 0; ks < 8; ++ks) vn[a][ks] = *(const bf16x8*)(vp + a * 16 * 256 + ks * 32);
          }
          if (first) { MO_BARRIER; first = false; }
          psteps(j, std::false_type{});
#pragma unroll
          for (int a = 0; a < 2; ++a)
#pragma unroll
            for (int ks = 0; ks < 8; ++ks) vf[a][ks] = vn[a][ks];
        }
        if (first) { MO_BARRIER; first = false; }
        psteps(blk, std::true_type{});
      }
    }
    __syncthreads();
    {
      const int t = tid >> 1, hf = tid & 1;
      const float il = 1.0f / lsl[t];
      bf16_t* dst = (dry ? (bf16_t*)((unsigned char*)p.out + 64 * MiB) : Mq) + qbase + (long)t * 64 + hf * 32;
#pragma unroll
      for (int i = 0; i < 4; ++i) {
        const f32x4 a = *(const LAS f32x4*)(oacc + mo_oidx(t, hf * 8 + 2 * i)), c = *(const LAS f32x4*)(oacc + mo_oidx(t, hf * 8 + 2 * i + 1));
        u32x4 w4; w4.x = pk2(a[0] * il, a[1] * il); w4.y = pk2(a[2] * il, a[3] * il); w4.z = pk2(c[0] * il, c[1] * il); w4.w = pk2(c[2] * il, c[3] * il);
        *(u32x4*)(dst + 8 * i) = w4;
      }
    }
    __syncthreads();
  }
}

constexpr int RO_Q = 0, RO_K = 32768, RO_P = 65536  , RO_PART = 98304, RO_STAT = RO_PART + 8192, RO_TB = 0, RO_TBW = 10240;
DI void ret_out_phase(const Params& p, LAS unsigned char* shm, int mode = 0) {
  const bool dry = mode != 0;
  unsigned char* ws = p.ws;
  int tid_ = threadIdx.x; asm volatile("" : "+v"(tid_)); const int tid = tid_, wid = __builtin_amdgcn_readfirstlane(tid >> 6), lane = tid & 63, fr = lane & 15, fq = lane >> 4;
  const bf16_t* Qr = (const bf16_t*)(ws + OFF_QR); const bf16_t* Kr = (const bf16_t*)(ws + OFF_KR); const bf16_t* Vrt = (const bf16_t*)(ws + OFF_VRT);
  const bf16_t* RT = (const bf16_t*)p.out;
  bf16_t* G = (bf16_t*)(ws + OFF_G);
#define RO_BARRIER do { asm volatile("s_waitcnt lgkmcnt(0)" ::: "memory"); __builtin_amdgcn_s_barrier(); asm volatile("" ::: "memory"); } while (0)
  for (int u = blockIdx.x; u < 1024; u += gridDim.x) {
    const int bh = u >> 6, c = u & 63, h = bh & 3, b = bh >> 2;
    const float gam = exp2f(lg2gamma(h));
    {
      const u32x4* qg = (const u32x4*)(Qr + (long)(bh * 64 + c) * 16384); const u32x4* kg = (const u32x4*)(Kr + (long)(bh * 64 + c) * 16384);
      u32x4 qv[4], kv[4];
#pragma unroll
      for (int i = 0; i < 4; ++i) { qv[i] = qg[tid + i * NTHREADS]; kv[i] = kg[tid + i * NTHREADS]; }
#pragma unroll
      for (int i = 0; i < 4; ++i) { *(LAS u32x4*)(shm + RO_Q + (tid + i * NTHREADS) * 16) = qv[i]; *(LAS u32x4*)(shm + RO_K + (tid + i * NTHREADS) * 16) = kv[i]; }
    }
    bf16x8 rf[2][4], vf[2][4];
    {
      const bf16_t* rp = RT + (long)(bh * 64 + c) * 32768 + (2 * wid) * 2048 + lane * 8;
      const bf16_t* vp = Vrt + (long)(bh * 64 + c) * 32768 + (2 * wid) * 2048 + lane * 8;
#pragma unroll
      for (int e2 = 0; e2 < 2; ++e2)
#pragma unroll
        for (int ks = 0; ks < 4; ++ks) { rf[e2][ks] = *(const bf16x8*)(rp + e2 * 2048 + ks * 512); vf[e2][ks] = *(const bf16x8*)(vp + e2 * 2048 + ks * 512); }
    }
    RO_BARRIER;
    {
      const int ns2 = (16 * wid + 15) / 32 + 1, n = 16 * wid + fr;
      bf16x8 qb[4];
#pragma unroll
      for (int ks = 0; ks < 4; ++ks) qb[ks] = *(const LAS bf16x8*)(shm + RO_Q + (wid * 4 + ks) * 1024 + lane * 16);
      for (int s2 = 0; s2 < ns2; ++s2) {
        f32x4 s[2];
#pragma unroll
        for (int par = 0; par < 2; ++par) {
          s[par] = (f32x4){0.f, 0.f, 0.f, 0.f};
#pragma unroll
          for (int ks = 0; ks < 4; ++ks) { const bf16x8 kf = *(const LAS bf16x8*)(shm + RO_K + ((s2 * 2 + par) * 4 + ks) * 1024 + lane * 16); s[par] = MFMA16(kf, qb[ks], s[par]); }
#pragma unroll
          for (int i = 0; i < 4; ++i) { const int key2 = 32 * s2 + fq * 8 + 4 * par + i; if (key2 > n) s[par][i] = 0.f; }
        }
        u32x4 pw; pw.x = pk2(s[0][0], s[0][1]); pw.y = pk2(s[0][2], s[0][3]); pw.z = pk2(s[1][0], s[1][1]); pw.w = pk2(s[1][2], s[1][3]);
        *(LAS u32x4*)(shm + RO_P + (wid * 4 + s2) * 1024 + lane * 16) = pw;
      }
    }
    RO_BARRIER;
    f32x4 o[2][8];
#pragma unroll
    for (int e2 = 0; e2 < 2; ++e2)
#pragma unroll
      for (int nt = 0; nt < 8; ++nt) o[e2][nt] = (f32x4){0.f, 0.f, 0.f, 0.f};
#pragma unroll
    for (int nt = 0; nt < 8; ++nt) {
#pragma unroll
      for (int ks = 0; ks < 4; ++ks) {
        const bf16x8 qB = *(const LAS bf16x8*)(shm + RO_Q + (nt * 4 + ks) * 1024 + lane * 16);
        o[0][nt] = MFMA16(rf[0][ks], qB, o[0][nt]); o[1][nt] = MFMA16(rf[1][ks], qB, o[1][nt]);
      }
    }
#pragma unroll
    for (int nt = 0; nt < 8; ++nt) {
      o[0][nt] = o[0][nt] * gam; o[1][nt] = o[1][nt] * gam;
#pragma unroll
      for (int s2 = 0; s2 < (16 * nt + 15) / 32 + 1; ++s2) {
        const bf16x8 pB = *(const LAS bf16x8*)(shm + RO_P + (nt * 4 + s2) * 1024 + lane * 16);
        o[0][nt] = MFMA16(vf[0][s2], pB, o[0][nt]); o[1][nt] = MFMA16(vf[1][s2], pB, o[1][nt]);
      }
    }
    {
      LAS f32x2* part = (LAS f32x2*)(shm + RO_PART);
#pragma unroll
      for (int nt = 0; nt < 8; ++nt) {
        float s1 = 0.f, s2q = 0.f;
#pragma unroll
        for (int e2 = 0; e2 < 2; ++e2)
#pragma unroll
          for (int i = 0; i < 4; ++i) { const float v = o[e2][nt][i]; s1 += v; s2q += v * v; }
        s1 += __shfl_xor(s1, 16); s1 += __shfl_xor(s1, 32); s2q += __shfl_xor(s2q, 16); s2q += __shfl_xor(s2q, 32);
        if (fq == 0) part[wid * 128 + nt * 16 + fr] = (f32x2){s1, s2q};
      }
    }
    RO_BARRIER;
    if (tid < 128) {
      const LAS f32x2* part = (const LAS f32x2*)(shm + RO_PART);
      float s1 = 0.f, s2q = 0.f;
#pragma unroll
      for (int w = 0; w < 8; ++w) { const f32x2 v = part[w * 128 + tid]; s1 += v.x; s2q += v.y; }
      const float mu = s1 * (1.0f / 256.0f), var = fmaxf(s2q * (1.0f / 256.0f) - mu * mu, 0.f);
      ((LAS f32x2*)(shm + RO_STAT))[tid] = (f32x2){mu, __builtin_amdgcn_rsqf(var + 1e-5f)};
    }
    RO_BARRIER;
    {
      LAS unsigned char* tb = shm + RO_TB + wid * RO_TBW;
#pragma unroll
      for (int nt = 0; nt < 8; ++nt) {
        const f32x2 st = ((const LAS f32x2*)(shm + RO_STAT))[nt * 16 + fr];
#pragma unroll
        for (int e2 = 0; e2 < 2; ++e2) *(LAS u32x2*)(tb + (nt * 16 + fr) * 80 + (e2 * 16 + 4 * fq) * 2) = pk4((o[e2][nt] - st.x) * st.y);
      }
      asm volatile("s_waitcnt lgkmcnt(0)" ::: "memory");
      bf16_t* gbase = G + ((long)b * SEQ + c * 128) * 1024 + h * 256 + 32 * wid;
      bf16_t* obase = dry ? (bf16_t*)((unsigned char*)p.out + 64 * MiB) + (gbase - G) : gbase;
      u32x4 gv[8];
#pragma unroll
      for (int r = 0; r < 8; ++r) { const int idx = r * 64 + lane; gv[r] = *(const u32x4*)(gbase + (long)(idx >> 2) * 1024 + (idx & 3) * 8); }
#pragma unroll
      for (int r = 0; r < 8; ++r) {
        const int idx = r * 64 + lane, nn = idx >> 2, ch = idx & 3;
        const u32x4 ov = *(const LAS u32x4*)(tb + nn * 80 + ch * 16);
        u32x4 w4;
        { const f32x4 a = unpk4((u32x2){ov.x, ov.y}) * unpk4((u32x2){gv[r].x, gv[r].y}), c2 = unpk4((u32x2){ov.z, ov.w}) * unpk4((u32x2){gv[r].z, gv[r].w});
          w4.x = pk2(a[0], a[1]); w4.y = pk2(a[2], a[3]); w4.z = pk2(c2[0], c2[1]); w4.w = pk2(c2[2], c2[3]); }
        *(u32x4*)(obase + (long)nn * 1024 + ch * 8) = w4;
      }
    }
    __syncthreads();
  }
}

struct SeqMerge {
  const Params& p; bf16_t* tmpb; bf16_t* mixb;
  DI bool get(int i, GUnit& u) const {
    int pm, pn;
    if (!tile_map(i >> 1, 128, 4, pm, pn)) return false;
    unsigned char* ws = p.ws;
    if ((i & 1) == 0) { const int b = pm >> 5, t0 = (pm & 31) * 256;
      u.Ap = (const bf16_t*)(ws + OFF_MQ) + ((long)b * 8 * SEQ + t0) * 64; u.lda = 64; u.ksa = (long)SEQ * 64; u.Bp = (const bf16_t*)(ws + OFF_WMO) + (long)pn * 256 * 512; u.ldb = 512; u.ksb = 64; u.nt = 8; }
    else { u.Ap = (const bf16_t*)(ws + OFF_G) + (long)pm * 256 * 1024; u.lda = 1024; u.ksa = 64; u.Bp = (const bf16_t*)(ws + OFF_WRO) + (long)pn * 256 * 1024; u.ldb = 1024; u.ksb = 64; u.nt = 16; }
    u.pm = pm; u.pn = pn | ((i & 1) << 4); u.permB = 0;
    return true;
  }
  DI void epi(f32x4 (&acc)[2][2][4][2], const GUnit& u) const {
    unsigned char* ws = p.ws;
    int tid_ = threadIdx.x; asm volatile("" : "+v"(tid_)); const int tid = tid_, wid = tid >> 6, lane = tid & 63, wr = wid >> 2, wc = wid & 3, fr = lane & 15, fq = lane >> 4;
    const int pn = u.pn & 15; const bool pass2 = (u.pn >> 4) != 0;
    const bf16_t* gate = (const bf16_t*)(ws + (pass2 ? OFF_GA : OFF_GB)); bf16_t* dst = pass2 ? mixb : tmpb;
#pragma unroll
    for (int ai = 0; ai < 2; ++ai) {
      u32x4 g4[4][2], t4[4][2];
#pragma unroll
      for (int m = 0; m < 4; ++m)
#pragma unroll
        for (int bj = 0; bj < 2; ++bj) { const long off = ((long)u.pm * 256 + 128 * ai + 64 * wr + 16 * m + fr) * 1024 + pn * 256 + 128 * bj + 32 * wc + 8 * fq;
          g4[m][bj] = *(const u32x4*)(gate + off); t4[m][bj] = pass2 ? *(const u32x4*)(tmpb + off) : (u32x4){0u, 0u, 0u, 0u}; }
      asm volatile("" ::: "memory");
#pragma unroll
      for (int m = 0; m < 4; ++m)
#pragma unroll
        for (int bj = 0; bj < 2; ++bj) {
          const long off = ((long)u.pm * 256 + 128 * ai + 64 * wr + 16 * m + fr) * 1024 + pn * 256 + 128 * bj + 32 * wc + 8 * fq;
          f32x4 v0 = unpk4((u32x2){g4[m][bj].x, g4[m][bj].y}) * acc[ai][bj][m][0], v1 = unpk4((u32x2){g4[m][bj].z, g4[m][bj].w}) * acc[ai][bj][m][1];
          v0 += unpk4((u32x2){t4[m][bj].x, t4[m][bj].y}); v1 += unpk4((u32x2){t4[m][bj].z, t4[m][bj].w});
          const u32x2 h0 = pk4(v0), h1 = pk4(v1);
          *(u32x4*)(dst + off) = (u32x4){h0.x, h0.y, h1.x, h1.y};
        }
      asm volatile("" ::: "memory");
    }
  }
};
DI void phase_merge(const Params& p, LAS unsigned char* shm, bool dry = false) {
  const SeqMerge seq{p, dry ? (bf16_t*)p.out : (bf16_t*)(p.ws + OFF_GB), dry ? (bf16_t*)((unsigned char*)p.out + 64 * MiB) : (bf16_t*)(p.ws + OFF_GA)};
  gemm_stream(seq, shm);
}

struct SeqWo {
  const Params& p; LAS unsigned char* shm;
  DI bool get(int i, GUnit& u) const {
    int pm, pn;
    if (!tile_map(i, 128, 4, pm, pn)) return false;
    u.Ap = (const bf16_t*)(p.ws + OFF_GA) + (long)pm * 256 * 1024; u.Bp = (const bf16_t*)(p.ws + OFF_WO) + (long)pn * 256 * 1024;
    u.lda = 1024; u.ldb = 1024; u.ksa = 64; u.ksb = 64; u.nt = 16; u.pm = pm; u.pn = pn; u.permB = 0;
    return true;
  }
  DI void epi(f32x4 (&acc)[2][2][4][2], const GUnit& u) const {
    unsigned char* ws = p.ws;
    int tid_ = threadIdx.x; asm volatile("" : "+v"(tid_)); const int tid = tid_, wid = tid >> 6, lane = tid & 63, wr = wid >> 2, wc = wid & 3, fr = lane & 15, fq = lane >> 4;
    LAS float* red = (LAS float*)(shm + 131072);
    const int pm = u.pm, pn = u.pn;
#pragma unroll
    for (int ai = 0; ai < 2; ++ai) {
      f32x4 pre[4][2][2];
#pragma unroll
      for (int m = 0; m < 4; ++m)
#pragma unroll
        for (int bj = 0; bj < 2; ++bj) { const long off = ((long)pm * 256 + 128 * ai + 64 * wr + 16 * m + fr) * 1024 + pn * 256 + 128 * bj + 32 * wc + 8 * fq;
          pre[m][bj][0] = *(const f32x4*)(p.x + off); pre[m][bj][1] = *(const f32x4*)(p.x + off + 4); }
      asm volatile("" ::: "memory");
#pragma unroll
      for (int m = 0; m < 4; ++m) {
        const int rl = 128 * ai + 64 * wr + 16 * m + fr;
        const long row = (long)pm * 256 + rl;
        float ss = 0.f;
#pragma unroll
        for (int bj = 0; bj < 2; ++bj) {
          const long off = row * 1024 + pn * 256 + 128 * bj + 32 * wc + 8 * fq;
          const f32x4 v0 = pre[m][bj][0] + acc[ai][bj][m][0], v1 = pre[m][bj][1] + acc[ai][bj][m][1];
          *(f32x4*)(p.out + off) = v0; *(f32x4*)(p.out + off + 4) = v1;
          const u32x2 h0 = pk4(v0), h1 = pk4(v1);
          *(u32x4*)((bf16_t*)(ws + OFF_X1B) + off) = (u32x4){h0.x, h0.y, h1.x, h1.y};
          ss += ((v0[0] * v0[0] + v0[1] * v0[1]) + (v0[2] * v0[2] + v0[3] * v0[3])) + ((v1[0] * v1[0] + v1[1] * v1[1]) + (v1[2] * v1[2] + v1[3] * v1[3]));
        }
        ss += __shfl_xor(ss, 16); ss += __shfl_xor(ss, 32);
        if (fq == 0) red[wc * 256 + rl] = ss;
      }
      asm volatile("" ::: "memory");
    }
    __syncthreads();
    if (tid < 256) ((float*)(ws + OFF_SSQ))[((long)pm * 256 + tid) * 4 + pn] = (red[tid] + red[256 + tid]) + (red[512 + tid] + red[768 + tid]);
    __syncthreads();
  }
};
DI void phase_wo(const Params& p, LAS unsigned char* shm) {
  const SeqWo seq{p, shm};
  gemm_stream(seq, shm);
}

DI void epi_gu(const Params& p, f32x4 (&acc)[2][2][4][2], int pm, int pn, int emode = 0) {
  unsigned char* ws = p.ws;
  int tid_ = threadIdx.x; asm volatile("" : "+v"(tid_)); const int tid = tid_, wid = tid >> 6, lane = tid & 63, wr = wid >> 2, wc = wid & 3, fr = lane & 15, fq = lane >> 4;
  const float* ssq = (const float*)(ws + OFF_SSQ);
  float rsr[2][4];
#pragma unroll
  for (int ai = 0; ai < 2; ++ai)
#pragma unroll
    for (int m = 0; m < 4; ++m) { const long row = (long)pm * 256 + 128 * ai + 64 * wr + 16 * m + fr;
      const f32x4 s4 = *(const f32x4*)(ssq + row * 4);
      rsr[ai][m] = __builtin_amdgcn_rsqf(((s4[0] + s4[1]) + (s4[2] + s4[3])) * (1.0f / DM) + 1e-6f); }
#pragma unroll
  for (int ai = 0; ai < 2; ++ai)
#pragma unroll
    for (int m = 0; m < 4; ++m) { asm volatile("" ::: "memory");
      const long row = (long)pm * 256 + 128 * ai + 64 * wr + 16 * m + fr;
      const float rs = rsr[ai][m];
      {
        u32x2 h[2];
#pragma unroll
        for (int n = 0; n < 2; ++n) {
          const f32x4 g = acc[ai][0][m][n] * rs, uu = acc[ai][1][m][n] * rs; f32x4 o;
#pragma unroll
          for (int j = 0; j < 4; ++j) o[j] = g[j] * sigmoidf_(g[j]) * uu[j];
          h[n] = pk4(o);
        }
        *(u32x4*)((bf16_t*)(ws + OFF_HID) + row * FH + pn * 128 + 32 * wc + 8 * fq) = (u32x4){h[0].x, h[0].y, h[1].x, h[1].y};
      }
    }
}
struct SeqGu {
  const Params& p; int emode;
  DI bool get(int i, GUnit& u) const {
    int pm, pn;
    if (!tile_map(i, 128, 22, pm, pn)) return false;
    u.Ap = (const bf16_t*)(p.ws + OFF_X1B) + (long)pm * 256 * 1024; u.Bp = (const bf16_t*)(p.ws + OFF_WGU) + (long)pn * 256 * 1024;
    u.lda = 1024; u.ldb = 1024; u.ksa = 64; u.ksb = 64; u.nt = 16; u.pm = pm; u.pn = pn; u.permB = 0;
    return true;
  }
  DI void epi(f32x4 (&acc)[2][2][4][2], const GUnit& u) const { if (emode != 2 || p.x == nullptr) epi_gu(p, acc, u.pm, u.pn, emode); }
};
DI void phase_gu(const Params& p, LAS unsigned char* shm, int emode = 0) {
  const SeqGu seq{p, emode};
  gemm_stream(seq, shm);
}

struct SeqDown {
  const Params& p; float* outw;
  DI bool get(int i, GUnit& u) const {
    int pm, pn;
    if (!tile_map(i, 128, 4, pm, pn)) return false;
    u.Ap = (const bf16_t*)(p.ws + OFF_HID) + (long)pm * 256 * FH; u.Bp = (const bf16_t*)(p.ws + OFF_WD) + (long)pn * 256 * FH;
    u.lda = FH; u.ldb = FH; u.ksa = 64; u.ksb = 64; u.nt = FH / 64; u.pm = pm; u.pn = pn; u.permB = 0;
    return true;
  }
  DI void epi(f32x4 (&acc)[2][2][4][2], const GUnit& u) const {
    int tid_ = threadIdx.x; asm volatile("" : "+v"(tid_)); const int tid = tid_, wid = tid >> 6, lane = tid & 63, wr = wid >> 2, wc = wid & 3, fr = lane & 15, fq = lane >> 4;
    const long cbase = ((long)u.pm * 256 + 64 * wr + fr) * 1024 + u.pn * 256 + 32 * wc + 4 * fq;
#pragma unroll
    for (int ai = 0; ai < 2; ++ai) {
      f32x4 pre[4][2][2];
#pragma unroll
      for (int m = 0; m < 4; ++m)
#pragma unroll
        for (int bj = 0; bj < 2; ++bj)
#pragma unroll
          for (int n = 0; n < 2; ++n) pre[m][bj][n] = *(const f32x4*)(p.out + cbase + (long)(128 * ai + 16 * m) * 1024 + 128 * bj + 16 * n);
      asm volatile("" ::: "memory");
#pragma unroll
      for (int m = 0; m < 4; ++m)
#pragma unroll
        for (int bj = 0; bj < 2; ++bj)
#pragma unroll
          for (int n = 0; n < 2; ++n) *(f32x4*)(outw + cbase + (long)(128 * ai + 16 * m) * 1024 + 128 * bj + 16 * n) = pre[m][bj][n] + acc[ai][bj][m][n];
      asm volatile("" ::: "memory");
    }
  }
};
DI void phase_down(const Params& p, LAS unsigned char* shm, bool dry = false) {
  const SeqDown seq{p, dry ? (float*)(p.ws + OFF_MK) : p.out};
  gemm_stream(seq, shm);
}

#define XB_TMO      128
#define XB_XCNT(j)  (256  + 64 * (j))
#define XB_XSUB(j)  (1280 + 64 * (j))
#define XB_XGEN(j)  (2304 + 64 * (j))
#define XB_TOP      3328
#define XB_TOPGEN   3392
#define XCD_BAR_WORDS 3456
#define XB_SPIN_CAP (1u << 18)
DI unsigned xb_ld(unsigned* p) { return __hip_atomic_load(p, __ATOMIC_RELAXED, __HIP_MEMORY_SCOPE_AGENT); }
DI unsigned xb_add(unsigned* p, unsigned v) { return __hip_atomic_fetch_add(p, v, __ATOMIC_RELAXED, __HIP_MEMORY_SCOPE_AGENT); }
DI unsigned xb_xcc_id() { return (unsigned)__builtin_amdgcn_s_getreg((3 << 11) | 20) & 0xFu; }
#define XB_SPIN(cond, bar) do { unsigned _sp = 0; while (cond) { __builtin_amdgcn_s_sleep(1); \
    if ((++_sp & 255u) == 0u) { if (xb_ld(&(bar)[XB_TMO])) break; if (_sp > XB_SPIN_CAP) { atomicAdd(&(bar)[XB_TMO], 1u); break; } } } } while (0)
struct XcdBarrier { unsigned* bar; unsigned x; volatile LAS unsigned* st; };
DI XcdBarrier xcd_barrier_post(unsigned* bar, volatile LAS unsigned* st) {
  XcdBarrier b; b.bar = bar; b.x = xb_xcc_id(); b.st = st;
  if (threadIdx.x == 0) (void)xb_add(&bar[XB_XCNT(b.x)], 1u);
  return b;
}
DI void xcd_barrier_complete(unsigned* bar, unsigned x, unsigned& nloc, unsigned& nx) {
  const unsigned G = gridDim.x * gridDim.y * gridDim.z;
  unsigned sum, cnt, mine, sp = 0u;
  for (;;) {
    sum = 0u; cnt = 0u; mine = 0u;
#pragma unroll
    for (unsigned j = 0; j < 16; ++j) { const unsigned c = xb_ld(&bar[XB_XCNT(j)]); sum += c; cnt += (c > 0u) ? 1u : 0u; mine = (j == x) ? c : mine; }
    if (sum == G) break;
    __builtin_amdgcn_s_sleep(1);
    if ((++sp & 255u) == 0u) { if (xb_ld(&bar[XB_TMO])) break; if (sp > XB_SPIN_CAP) { atomicAdd(&bar[XB_TMO], 1u); break; } }
  }
  nloc = mine > 0u ? mine : 1u; nx = cnt > 0u ? cnt : 1u;
}
DI void xcd_barrier(const XcdBarrier& b) {
  asm volatile("s_waitcnt vmcnt(0)" ::: "memory");
  __syncthreads();
  if (threadIdx.x == 0) {
    unsigned* bar = b.bar;
    __builtin_amdgcn_s_waitcnt(0);
    unsigned nloc = b.st[0], nx = b.st[1];
    if (nloc == 0u) { xcd_barrier_complete(bar, b.x, nloc, nx); b.st[0] = nloc; b.st[1] = nx; }
    const unsigned old = xb_add(&bar[XB_XSUB(b.x)], 1u);
    const unsigned gen = old / nloc;
    if (old + 1u == (gen + 1u) * nloc) {
      __builtin_amdgcn_fence(__ATOMIC_RELEASE, "agent");
      asm volatile("s_waitcnt vmcnt(0)" ::: "memory");
      const unsigned og = xb_add(&bar[XB_TOP], 1u);
      const unsigned tg = og / nx;
      if (og + 1u == (tg + 1u) * nx) xb_add(&bar[XB_TOPGEN], 1u);
      else XB_SPIN(xb_ld(&bar[XB_TOPGEN]) == tg, bar);
      __builtin_amdgcn_fence(__ATOMIC_ACQUIRE, "agent");
      xb_add(&bar[XB_XGEN(b.x)], 1u);
      asm volatile("s_waitcnt vmcnt(0)" ::: "memory");
    } else {
      XB_SPIN(xb_ld(&bar[XB_XGEN(b.x)]) == gen, bar);
      __builtin_amdgcn_fence(__ATOMIC_ACQUIRE, "agent");
      asm volatile("s_waitcnt vmcnt(0)" ::: "memory");
    }
  }
  __syncthreads();
}

__global__ void __launch_bounds__(NTHREADS) fwd_megakernel(Params p) {
  extern __shared__ __attribute__((aligned(16))) unsigned char shm_raw[];
  LAS unsigned char* shm = (LAS unsigned char*)shm_raw;
  cg::grid_group grid = cg::this_grid();
  volatile LAS unsigned* xst = (volatile LAS unsigned*)(shm + LDS_BYTES - 16);
  if (threadIdx.x == 0) { xst[0] = 0u; xst[1] = 0u; }
  unsigned* bar = (unsigned*)(p.ws + OFF_BAR);
  __syncthreads();
  const XcdBarrier xb = xcd_barrier_post(bar, xst);
  phase0(p, shm);
  if (p.x == nullptr) grid.sync();
  xcd_barrier(xb);
  phase1(p, shm);
  xcd_barrier(xb);
  ret_scan(p, shm);
  moba_phase(p, shm);
  xcd_barrier(xb);
  ret_out_phase(p, shm);
  xcd_barrier(xb);
  phase_merge(p, shm);
  xcd_barrier(xb);
  phase_wo(p, shm);
  xcd_barrier(xb);
  phase_gu(p, shm);
  xcd_barrier(xb);
  phase_down(p, shm);
}

extern "C" void kernel_launch(void* const* d_in, const int* in_sizes, int n_in, void* d_out, int out_size, void* d_ws, size_t ws_size, hipStream_t stream) {
  static int grid_blocks = 0;
  if (grid_blocks == 0) {
    if (n_in != 12 || out_size != T_TOK * DM || ws_size < WS_END) { fprintf(stderr, "kernel_launch: unexpected shapes / workspace (n_in %d out %d ws %zu need %zu)\n", n_in, out_size, ws_size, (size_t)WS_END); grid_blocks = -1; return; }
    int dev = 0, cus = 0, per_cu = 0;
    hipGetDevice(&dev);
    hipDeviceGetAttribute(&cus, hipDeviceAttributeMultiprocessorCount, dev);
    if (hipFuncSetAttribute((const void*)fwd_megakernel, hipFuncAttributeMaxDynamicSharedMemorySize, LDS_BYTES) != hipSuccess) { fprintf(stderr, "hipFuncSetAttribute failed\n"); grid_blocks = -1; return; }
    hipOccupancyMaxActiveBlocksPerMultiprocessor(&per_cu, (const void*)fwd_megakernel, NTHREADS, LDS_BYTES);
    if (per_cu < 1) { fprintf(stderr, "occupancy query says %d blocks/CU\n", per_cu); per_cu = 1; }
    if (per_cu > 1) per_cu = 1;
    grid_blocks = cus * per_cu;
  }
  if (grid_blocks < 0) return;
  Params p{};
  p.x = (const float*)d_in[0]; p.norm1_w = (const float*)d_in[1]; p.w_in = (const float*)d_in[2]; p.q_norm_w = (const float*)d_in[3]; p.k_norm_w = (const float*)d_in[4];
  p.w_ret_out = (const float*)d_in[5]; p.w_moba_out = (const float*)d_in[6]; p.w_o = (const float*)d_in[7]; p.norm2_w = (const float*)d_in[8];
  p.w_gate = (const float*)d_in[9]; p.w_up = (const float*)d_in[10]; p.w_down = (const float*)d_in[11];
  p.out = (float*)d_out; p.ws = (unsigned char*)d_ws;
  void* args[] = {&p};
  if (hipMemsetAsync((unsigned char*)d_ws + OFF_BAR, 0, 16384, stream) != hipSuccess) { fprintf(stderr, "hipMemsetAsync of the barrier words failed\n"); return; }
  hipError_t e = hipLaunchCooperativeKernel((const void*)fwd_megakernel, dim3(grid_blocks), dim3(NTHREADS), args, LDS_BYTES, stream);
  if (e != hipSuccess) fprintf(stderr, "cooperative launch failed: %s (grid %d)\n", hipGetErrorString(e), grid_blocks);
}
```
